# Optimizing an MI355X kernel written in HIP

```python
import math
import jax, jax.numpy as jnp
from jax import lax
import numpy as np

D_MODEL = 1024
BATCH = 8
SEQ = 4096
DEPTH = 2

GRID_W = 64
CTX_LEN = 256
MIX_W = D_MODEL
GROUP_W = MIX_W // 4
HEAD_DIM = 64
A_HEADS = GROUP_W // HEAD_DIM
A_KV_HEADS = 2
CONV_W = 31
FNET_GROUPS = 4
D_HEADS = 4
D_VDIM = GROUP_W // D_HEADS
D_QKDIM = D_VDIM // 2
N_EXPERTS = 32
TOP_K = 4
D_FF = D_MODEL
SWIGLU_LIMIT = 7.0
SWIGLU_ALPHA = 1.702
MOE_BLOCK = 256
Q_BLOCK = 128
ROPE_THETA = 10000.0
EPS = 1e-6

A_Q_W = A_HEADS * HEAD_DIM
A_KV_W = A_KV_HEADS * HEAD_DIM
D_QK_W = D_HEADS * 2 * D_QKDIM
D_V_W = D_HEADS * D_VDIM
IN_WIDTHS = (A_Q_W, A_KV_W, A_KV_W, GROUP_W, GROUP_W, GROUP_W, D_QK_W, D_QK_W, D_V_W)
D_IN = A_Q_W + 2 * A_KV_W + 3 * GROUP_W + 2 * D_QK_W + D_V_W

kernel_name = 'hybrid_diffusion_parallel_groups_moe'


def rms_norm(x, g):
    xf = x.astype(jnp.float32)
    y = xf * lax.rsqrt(jnp.mean(xf * xf, axis=-1, keepdims=True) + EPS)
    return (y * g.astype(jnp.float32)).astype(x.dtype)


def layer_norm(x, g, b):
    xf = x.astype(jnp.float32)
    mu = jnp.mean(xf, axis=-1, keepdims=True)
    xc = xf - mu
    y = xc * lax.rsqrt(jnp.mean(xc * xc, axis=-1, keepdims=True) + EPS)
    return (y * g.astype(jnp.float32) + b.astype(jnp.float32)).astype(x.dtype)


def modulate(h, shift, scale):
    return h * (1 + scale) + shift


def split_cols(p):
    out, start = [], 0
    for w in IN_WIDTHS:
        out.append(p[..., start:start + w])
        start += w
    return out


def rope_rotate(x, pos):
    n = x.shape[-1]
    inv = jnp.power(ROPE_THETA, -jnp.arange(0, n, 2, dtype=jnp.float32) / n)
    ang = pos.astype(jnp.float32)[:, None] * inv[None, :]
    shape = (ang.shape[0],) + (1,) * (x.ndim - 3) + (n // 2,)
    cos = jnp.cos(ang).reshape(shape)
    sin = jnp.sin(ang).reshape(shape)
    xf = x.astype(jnp.float32)
    x1, x2 = xf[..., : n // 2], xf[..., n // 2:]
    return jnp.concatenate([x1 * cos - x2 * sin, x1 * sin + x2 * cos], axis=-1).astype(x.dtype)


def axial_rope(x, rows, cols):
    half = x.shape[-1] // 2
    return jnp.concatenate([rope_rotate(x[..., :half], rows), rope_rotate(x[..., half:], cols)], axis=-1)


def attn_heads(aq, ak, av, dq, dk, dv, a_qg, a_kg, d_qg, d_kg, rows, cols):
    B_, T_ = aq.shape[:2]
    aq = rms_norm(aq.reshape(B_, T_, A_KV_HEADS, A_HEADS // A_KV_HEADS, HEAD_DIM), a_qg)
    ak = rms_norm(ak.reshape(B_, T_, A_KV_HEADS, HEAD_DIM), a_kg)
    av = av.reshape(B_, T_, A_KV_HEADS, HEAD_DIM)
    dq = rms_norm(dq.reshape(B_, T_, D_HEADS, 2, D_QKDIM), d_qg)
    dk = rms_norm(dk.reshape(B_, T_, D_HEADS, 2, D_QKDIM), d_kg)
    dv = dv.reshape(B_, T_, D_HEADS, D_VDIM)
    if rows is not None:
        aq, ak = axial_rope(aq, rows, cols), axial_rope(ak, rows, cols)
        dq, dk = axial_rope(dq, rows, cols), axial_rope(dk, rows, cols)
    return aq, ak, av, dq, dk, dv


def gqa_block(q, k, v):
    s = jnp.einsum('bqhgd,bkhd->bhgqk', q, k).astype(jnp.float32) * (HEAD_DIM ** -0.5)
    p = jax.nn.softmax(s, axis=-1).astype(v.dtype)
    return jnp.einsum('bhgqk,bkhd->bqhgd', p, v)


def diff_block(q, k, v, lam):
    s = jnp.einsum('bqhcd,bkhcd->bchqk', q, k).astype(jnp.float32) * (D_QKDIM ** -0.5)
    p = jax.nn.softmax(s, axis=-1)
    a = (p[:, 0] - lam * p[:, 1]).astype(v.dtype)
    return jnp.einsum('bhqk,bkhd->bqhd', a, v)


def diff_out(o, g, lam_init):
    B_, T_ = o.shape[:2]
    return (rms_norm(o, g) * (1.0 - lam_init)).reshape(B_, T_, GROUP_W)


def sweep_queries(fn, q):
    B_, L_ = q.shape[:2]
    nb = L_ // Q_BLOCK
    qb = jnp.moveaxis(q.reshape((B_, nb, Q_BLOCK) + q.shape[2:]), 1, 0)
    ob = jnp.moveaxis(lax.map(fn, qb), 0, 1)
    return ob.reshape((B_, L_) + ob.shape[3:])


def conformer_conv(u, gate, w_dw, b_dw, ln_g, ln_b):
    z = u * jax.nn.sigmoid(gate)
    z = lax.conv_general_dilated(
        z, w_dw[:, None, :], window_strides=(1,), padding=[(CONV_W // 2, CONV_W // 2)],
        dimension_numbers=('NWC', 'WIO', 'NWC'), feature_group_count=z.shape[-1]) + b_dw
    return jax.nn.silu(layer_norm(z, ln_g, ln_b))


def fourier_mix(u):
    B_, L_, C_ = u.shape
    uf = u.astype(jnp.float32).reshape(B_, L_, FNET_GROUPS, C_ // FNET_GROUPS)
    y = jnp.fft.fft2(uf, axes=(1, 3), norm='ortho').real
    return y.reshape(B_, L_, C_).astype(u.dtype)


def moe(h, router_w, router_b, w_gu, b_gu, w_down, b_down):
    T = h.shape[0]
    logits = (h @ router_w + router_b).astype(jnp.float32)
    top_val, top_idx = lax.top_k(logits, TOP_K)
    gates = jax.nn.softmax(top_val, axis=-1)
    n_assign = T * TOP_K
    flat_e = top_idx.reshape(-1).astype(jnp.int32)
    flat_tok = jnp.arange(n_assign, dtype=jnp.int32) // TOP_K
    flat_w = gates.reshape(-1)
    order = jnp.argsort(flat_e)
    sorted_e, sorted_tok, sorted_w = flat_e[order], flat_tok[order], flat_w[order]
    counts = jnp.zeros((N_EXPERTS,), jnp.int32).at[flat_e].add(1)
    starts = jnp.cumsum(counts) - counts
    padded = (counts + MOE_BLOCK - 1) // MOE_BLOCK * MOE_BLOCK
    pad_ends = jnp.cumsum(padded)
    pad_starts = pad_ends - padded
    dest = pad_starts[sorted_e] + jnp.arange(n_assign, dtype=jnp.int32) - starts[sorted_e]
    n_blocks = -(-(n_assign + N_EXPERTS * (MOE_BLOCK - 1)) // MOE_BLOCK)
    P = n_blocks * MOE_BLOCK
    slot_tok = jnp.full((P,), T, jnp.int32).at[dest].set(sorted_tok)
    slot_w = jnp.zeros((P,), jnp.float32).at[dest].set(sorted_w)
    block_start = jnp.arange(n_blocks, dtype=jnp.int32) * MOE_BLOCK
    block_e = jnp.minimum(jnp.searchsorted(pad_ends, block_start, side='right'), N_EXPERTS - 1).astype(jnp.int32)
    h_pad = jnp.concatenate([h, jnp.zeros((1, h.shape[1]), h.dtype)], axis=0)

    def expert_block(args):
        tok, e, w = args
        xb = h_pad[tok]
        gu = xb @ w_gu[e] + b_gu[e]
        g, u = gu[:, :D_FF], gu[:, D_FF:]
        g = jnp.minimum(g, SWIGLU_LIMIT)
        u = jnp.clip(u, -SWIGLU_LIMIT, SWIGLU_LIMIT)
        act = g * jax.nn.sigmoid(SWIGLU_ALPHA * g) * (u + 1)
        return (act @ w_down[e] + b_down[e]) * w[:, None].astype(xb.dtype)

    yb = lax.map(expert_block, (slot_tok.reshape(n_blocks, MOE_BLOCK), block_e,
                                slot_w.reshape(n_blocks, MOE_BLOCK)))
    y = jax.ops.segment_sum(yb.reshape(P, -1), slot_tok, num_segments=T + 1)
    return y[:T]


def setup_inputs(seed: int = 0) -> dict:
    key = jax.random.key(seed)
    ks = jax.random.split(key, 26)
    f32 = jnp.float32
    D = D_MODEL

    def nrm(k, shape, scale):
        return jax.random.normal(k, shape, f32) * scale

    return {
        'x': nrm(ks[0], (BATCH, SEQ, D), 1.0),
        'c': nrm(ks[1], (BATCH, D), 1.0),
        'ctx': nrm(ks[2], (BATCH, CTX_LEN, D), 1.0),
        'c_ctx': nrm(ks[3], (D,), 1.0),
        'norm1_g': 1.0 + nrm(ks[4], (DEPTH, D), 0.02),
        'norm2_g': 1.0 + nrm(ks[5], (DEPTH, D), 0.02),
        'ada_w': nrm(ks[6], (DEPTH, D, 6 * D), 0.5 * D ** -0.5),
        'ada_b': nrm(ks[7], (DEPTH, 6 * D), 0.01),
        'w_in': nrm(ks[8], (DEPTH, D, D_IN), D ** -0.5),
        'a_qnorm_g': 1.0 + nrm(ks[9], (DEPTH, HEAD_DIM), 0.02),
        'a_knorm_g': 1.0 + nrm(ks[10], (DEPTH, HEAD_DIM), 0.02),
        'conv_dw_w': nrm(ks[11], (DEPTH, CONV_W, GROUP_W), CONV_W ** -0.5),
        'conv_dw_b': nrm(ks[12], (DEPTH, GROUP_W), 0.01),
        'conv_ln_g': 1.0 + nrm(ks[13], (DEPTH, GROUP_W), 0.02),
        'conv_ln_b': nrm(ks[14], (DEPTH, GROUP_W), 0.01),
        'd_qnorm_g': 1.0 + nrm(ks[15], (DEPTH, D_QKDIM), 0.02),
        'd_knorm_g': 1.0 + nrm(ks[16], (DEPTH, D_QKDIM), 0.02),
        'd_lambda': nrm(ks[17], (DEPTH, 4, D_QKDIM), 0.1),
        'd_subln_g': 1.0 + nrm(ks[18], (DEPTH, D_VDIM), 0.02),
        'w_out': nrm(ks[19], (DEPTH, MIX_W, D), MIX_W ** -0.5),
        'router_w': nrm(ks[20], (DEPTH, D, N_EXPERTS), D ** -0.5),
        'router_b': nrm(ks[21], (DEPTH, N_EXPERTS), 0.01),
        'exp_w_gu': nrm(ks[22], (DEPTH, N_EXPERTS, D, 2 * D_FF), D ** -0.5),
        'exp_b_gu': nrm(ks[23], (DEPTH, N_EXPERTS, 2 * D_FF), 0.01),
        'exp_w_down': nrm(ks[24], (DEPTH, N_EXPERTS, D_FF, D), D_FF ** -0.5),
        'exp_b_down': nrm(ks[25], (DEPTH, N_EXPERTS, D), 0.01),
    }


def reference(x, c, ctx, c_ctx, norm1_g, norm2_g, ada_w, ada_b, w_in, a_qnorm_g, a_knorm_g,
              conv_dw_w, conv_dw_b, conv_ln_g, conv_ln_b, d_qnorm_g, d_knorm_g, d_lambda,
              d_subln_g, w_out, router_w, router_b, exp_w_gu, exp_b_gu, exp_w_down, exp_b_down):
    B_, L, D = x.shape
    C_ = ctx.shape[1]
    ROWS = L // GRID_W
    rows = jnp.repeat(jnp.arange(ROWS, dtype=jnp.int32), GRID_W)
    cols = jnp.tile(jnp.arange(GRID_W, dtype=jnp.int32), ROWS)
    xc = ctx
    for li in range(DEPTH):
        last = li == DEPTH - 1
        mod = jax.nn.silu(c) @ ada_w[li] + ada_b[li]
        mod_c = jax.nn.silu(c_ctx) @ ada_w[li] + ada_b[li]
        sh1, sc1, g1, sh2, sc2, g2 = jnp.split(mod[:, None, :], 6, axis=-1)
        csh1, csc1, cg1, csh2, csc2, cg2 = jnp.split(mod_c[None, None, :], 6, axis=-1)

        h = modulate(rms_norm(x, norm1_g[li]), sh1, sc1)
        hc = modulate(rms_norm(xc, norm1_g[li]), csh1, csc1)
        aq, ak, av, bu, bg, cu, dq, dk, dv = split_cols(h @ w_in[li])
        aqc, akc, avc, buc, bgc, cuc, dqc, dkc, dvc = split_cols(hc @ w_in[li])
        aq, ak, av, dq, dk, dv = attn_heads(aq, ak, av, dq, dk, dv, a_qnorm_g[li], a_knorm_g[li],
                                            d_qnorm_g[li], d_knorm_g[li], rows, cols)
        aqc, akc, avc, dqc, dkc, dvc = attn_heads(aqc, akc, avc, dqc, dkc, dvc, a_qnorm_g[li], a_knorm_g[li],
                                                  d_qnorm_g[li], d_knorm_g[li], None, None)
        lam_init = 0.8 - 0.6 * math.exp(-0.3 * li)
        lq1, lk1, lq2, lk2 = d_lambda[li].astype(jnp.float32)
        lam = jnp.exp(jnp.sum(lq1 * lk1)) - jnp.exp(jnp.sum(lq2 * lk2)) + lam_init

        ka = jnp.concatenate([ak, akc], axis=1)
        va = jnp.concatenate([av, avc], axis=1)
        kd = jnp.concatenate([dk, dkc], axis=1)
        vd = jnp.concatenate([dv, dvc], axis=1)
        o_a = sweep_queries(lambda qb: gqa_block(qb, ka, va), aq).reshape(B_, L, GROUP_W)
        o_b = conformer_conv(bu, bg, conv_dw_w[li], conv_dw_b[li], conv_ln_g[li], conv_ln_b[li])
        o_c = fourier_mix(cu)
        o_d = diff_out(sweep_queries(lambda qb: diff_block(qb, kd, vd, lam), dq), d_subln_g[li], lam_init)
        x = x + g1 * (jnp.concatenate([o_a, o_b, o_c, o_d], axis=-1) @ w_out[li])

        if not last:
            oc_a = gqa_block(aqc, akc, avc).reshape(B_, C_, GROUP_W)
            oc_b = conformer_conv(buc, bgc, conv_dw_w[li], conv_dw_b[li], conv_ln_g[li], conv_ln_b[li])
            oc_c = fourier_mix(cuc)
            oc_d = diff_out(diff_block(dqc, dkc, dvc, lam), d_subln_g[li], lam_init)
            xc = xc + cg1 * (jnp.concatenate([oc_a, oc_b, oc_c, oc_d], axis=-1) @ w_out[li])

        h2 = modulate(rms_norm(x, norm2_g[li]), sh2, sc2).reshape(B_ * L, D)
        if last:
            y = moe(h2, router_w[li], router_b[li], exp_w_gu[li], exp_b_gu[li], exp_w_down[li], exp_b_down[li])
            x = x + g2 * y.reshape(B_, L, D)
        else:
            h2c = modulate(rms_norm(xc, norm2_g[li]), csh2, csc2).reshape(B_ * C_, D)
            y = moe(jnp.concatenate([h2, h2c], axis=0), router_w[li], router_b[li], exp_w_gu[li],
                    exp_b_gu[li], exp_w_down[li], exp_b_down[li])
            x = x + g2 * y[: B_ * L].reshape(B_, L, D)
            xc = xc + cg2 * y[B_ * L:].reshape(B_, C_, D)
    return x
```

```cpp
#include <hip/hip_runtime.h>
#include <stdint.h>
#include <stdio.h>

#define DI __device__ __forceinline__
#define LAS __attribute__((address_space(3)))
typedef unsigned short bf16_t;
typedef short bf16x8 __attribute__((ext_vector_type(8)));
typedef short s16x4 __attribute__((ext_vector_type(4)));
typedef float f32x2 __attribute__((ext_vector_type(2)));
typedef float f32x4 __attribute__((ext_vector_type(4)));
typedef float f32x16 __attribute__((ext_vector_type(16)));
typedef unsigned u32x2 __attribute__((ext_vector_type(2)));
typedef unsigned u32x4 __attribute__((ext_vector_type(4)));
typedef __bf16 bf16x2_t __attribute__((ext_vector_type(2)));
typedef int v4i __attribute__((ext_vector_type(4)));
typedef int v8i __attribute__((ext_vector_type(8)));

constexpr int DM = 1024, NB = 8, SEQ = 4096, CTX = 256, NLAT = NB * SEQ, NCTX = NB * CTX, NTOK = NLAT + NCTX, DEPTH = 2;
constexpr int NE = 32, TOPK = 4, KEYS = SEQ + CTX;
constexpr int NTILE_TOK = NTOK / 256;
constexpr int MAXMT = 576;
constexpr float EPS = 1e-6f;
constexpr float LOG2E = 1.4426950408889634f;
constexpr float W8_SCALE = 64.0f, W8_INV = 1.0f / 64.0f;

constexpr size_t al256(size_t x) { return (x + 255) & ~(size_t)255; }
constexpr size_t WS_BAR = 0;
constexpr size_t WS_CNT = 16384;
constexpr size_t WS_ZERO_BYTES = 20480;
constexpr size_t WS_MOD = WS_ZERO_BYTES;
constexpr size_t WS_ROPE = al256(WS_MOD + (size_t)DEPTH * 9 * 6144 * 4);
constexpr size_t WS_TOKE = al256(WS_ROPE + 3072 * 4);
constexpr size_t WS_TOKP = al256(WS_TOKE + (size_t)NTOK * 4 * 4);
constexpr size_t WS_TOKG = al256(WS_TOKP + (size_t)NTOK * 4 * 4);
constexpr size_t WS_TOKS = al256(WS_TOKG + (size_t)NTOK * 4 * 4);
constexpr size_t WS_WTOK = al256(WS_TOKS + (size_t)NTOK * 4 * 4);
constexpr size_t SZ_WTOK = (size_t)1536 * 1024 * 2;
constexpr size_t WS_WCH = WS_WTOK + DEPTH * SZ_WTOK;
constexpr size_t SZ_WCH = (size_t)1024 * 1024 * 2;
constexpr size_t WS_WOUT = WS_WCH + DEPTH * SZ_WCH;
constexpr size_t SZ_WOUT = (size_t)1024 * 1024 * 2;
constexpr size_t WS_WGU = WS_WOUT + DEPTH * SZ_WOUT;
constexpr size_t SZ_WGU = (size_t)NE * 2048 * 1024 * 2;
constexpr size_t WS_WDN = WS_WGU + DEPTH * SZ_WGU;
constexpr size_t SZ_WDN = (size_t)NE * 1024 * 1024 * 2;
constexpr size_t WS_TL = WS_WDN + DEPTH * SZ_WDN;
constexpr size_t WS_Y2 = WS_TL;
constexpr size_t WS_M1 = WS_TL + (size_t)NB * 64 * 256 * 128 * 2;
constexpr size_t WS_M3 = WS_M1 + 128 * 128 * 2;
constexpr size_t WS_TW = WS_M3 + 64 * 128 * 2;
constexpr size_t WS_TC = WS_TL + (size_t)4096 * 8192 * 2;
constexpr size_t WS_H = WS_TC + (size_t)256 * 512 * 2;
constexpr size_t WS_QA = WS_H + (size_t)NTOK * 1024 * 2;
constexpr size_t WS_KA = WS_QA + (size_t)NTOK * 256 * 2;
constexpr size_t WS_BU = WS_KA + (size_t)NTOK * 128 * 2;
constexpr size_t WS_BG = WS_BU + (size_t)NTOK * 256 * 2;
constexpr size_t WS_QD = WS_BG + (size_t)NTOK * 256 * 2;
constexpr size_t WS_KD = WS_QD + (size_t)NTOK * 256 * 2;
constexpr size_t WS_VTA = WS_KD + (size_t)NTOK * 256 * 2;
constexpr size_t WS_VTD = WS_VTA + (size_t)NB * 2 * 64 * KEYS * 2;
constexpr size_t WS_FT = WS_VTD + (size_t)NB * 4 * 64 * KEYS * 2;
constexpr size_t WS_FTC = WS_FT + (size_t)NB * 256 * 8192 * 2;
constexpr size_t WS_CAT = WS_FTC + (size_t)NB * 256 * 512 * 2;
constexpr size_t WS_X1 = WS_CAT + (size_t)NTOK * 1024 * 2;
constexpr size_t WS_X2 = WS_X1 + (size_t)NTOK * 1024 * 2;
constexpr size_t WS_XP = WS_X2 + (size_t)NTOK * 1024 * 2;
constexpr size_t WS_ACT = WS_XP + (size_t)MAXMT * 256 * 1024 * 2;
constexpr size_t WS_H8 = WS_ACT + (size_t)MAXMT * 256 * 1024 * 2;
constexpr size_t WS_TOKL = WS_H8 + (size_t)NTOK * 1024;
constexpr size_t WS_END = WS_TOKL + ((size_t)NE * NTOK + 1024) * 4;

constexpr int LDS_GEMM = 131072;
constexpr int LDS_TAB = LDS_GEMM;
constexpr int LDS_TOKT = LDS_TAB + 3072;
constexpr int LDS_BARW = LDS_GEMM + 4096;
constexpr int LDS_ROPE = LDS_BARW + 16;
constexpr int LDS_BYTES = LDS_ROPE + 65 * 48 * 4;

struct Params {
    const float* x; const float* c; const float* ctx; const float* c_ctx;
    const float* norm1_g; const float* norm2_g; const float* ada_w; const float* ada_b; const float* w_in;
    const float* a_qg; const float* a_kg; const float* conv_w; const float* conv_b; const float* conv_lg; const float* conv_lb;
    const float* d_qg; const float* d_kg; const float* d_lambda; const float* d_subg; const float* w_out;
    const float* router_w; const float* router_b; const float* w_gu; const float* b_gu; const float* w_dn; const float* b_dn;
    float* out; unsigned char* ws;
    int ph_lo, ph_hi;
};

#if defined(__HIP_DEVICE_COMPILE__)
typedef const Params __attribute__((address_space(4))) * KParamsPtr;
#else
typedef const Params* KParamsPtr;
#endif
DI KParamsPtr kparams() { KParamsPtr p = (KParamsPtr)__builtin_amdgcn_kernarg_segment_ptr(); asm volatile("" : "+s"(p)); return p; }
DI int ld_tid() { int t = threadIdx.x; asm volatile("" : "+v"(t)); return t; }
DI int vcu() { const int G = gridDim.x, c = blockIdx.x; return (G & 7) == 0 ? (c & 7) * (G >> 3) + (c >> 3) : c; }

DI unsigned pk2(float lo, float hi) { f32x2 v = {lo, hi}; bf16x2_t b = __builtin_convertvector(v, bf16x2_t); return __builtin_bit_cast(unsigned, b); }
DI unsigned pk4_fp8(float a, float b, float c, float d) { int r = 0; r = __builtin_amdgcn_cvt_pk_fp8_f32(a, b, r, false); r = __builtin_amdgcn_cvt_pk_fp8_f32(c, d, r, true); return (unsigned)r; }
DI float clamp448(float x) { return __builtin_amdgcn_fmed3f(x, -448.0f, 448.0f); }
DI float bf2f(bf16_t b) { return __uint_as_float(((unsigned)b) << 16); }
DI float bflo(unsigned u) { return __uint_as_float(u << 16); }
DI float bfhi(unsigned u) { return __uint_as_float(u & 0xffff0000u); }
DI float wave_sum(float v) {
#pragma unroll
    for (int o = 32; o >= 1; o >>= 1) v += __shfl_xor(v, o);
    return v;
}
DI float sum_x16_x32(float v) {
    { const auto r = __builtin_amdgcn_permlane16_swap(__float_as_uint(v), __float_as_uint(v), false, false); v = __uint_as_float(r[0]) + __uint_as_float(r[1]); }
    { const auto r = __builtin_amdgcn_permlane32_swap(__float_as_uint(v), __float_as_uint(v), false, false); v = __uint_as_float(r[0]) + __uint_as_float(r[1]); }
    return v;
}
DI float sigmoidf_(float x) { return 1.0f / (1.0f + __expf(-x)); }
DI int perm32(int rho) { const int n = rho >> 4, i = rho & 15; return 8 * (i >> 2) + 4 * n + (i & 3); }

#define XB_TMO      128
#define XB_XCNT(j)  (256  + 64 * (j))
#define XB_XSUB(j)  (1280 + 64 * (j))
#define XB_XGEN(j)  (2304 + 64 * (j))
#define XB_TOP      3328
#define XB_TOPGEN   3392
#define XCD_BAR_WORDS 3456
#define XB_SPIN_CAP (1u << 18)
DI unsigned xb_ld(unsigned* p)              { return __hip_atomic_load(p, __ATOMIC_RELAXED, __HIP_MEMORY_SCOPE_AGENT); }
DI unsigned xb_add(unsigned* p, unsigned v) { return __hip_atomic_fetch_add(p, v, __ATOMIC_RELAXED, __HIP_MEMORY_SCOPE_AGENT); }
DI unsigned xb_xcc_id() { return (unsigned)__builtin_amdgcn_s_getreg((3 << 11) | 20) & 0xFu; }
#define XB_SPIN(cond, bar) do { unsigned _sp = 0; while (cond) { __builtin_amdgcn_s_sleep(1); \
    if ((++_sp & 255u) == 0u) { if (xb_ld(&(bar)[XB_TMO])) break; if (_sp > XB_SPIN_CAP) { atomicAdd(&(bar)[XB_TMO], 1u); break; } } } } while (0)
struct XcdBarrier { unsigned* bar; unsigned x; volatile LAS unsigned* st; };
DI XcdBarrier xcd_barrier_post(unsigned* bar, volatile LAS unsigned* st) {
    XcdBarrier b; b.bar = bar; b.x = xb_xcc_id(); b.st = st;
    if (threadIdx.x == 0) (void)xb_add(&bar[XB_XCNT(b.x)], 1u);
    return b;
}
DI void xcd_barrier_complete(unsigned* bar, unsigned x, unsigned& nloc, unsigned& nx) {
    const unsigned G = gridDim.x * gridDim.y * gridDim.z;
    unsigned sum, cnt, mine, sp = 0u;
    for (;;) {
        sum = 0u; cnt = 0u; mine = 0u;
#pragma unroll
        for (unsigned j = 0; j < 16; ++j) { const unsigned c = xb_ld(&bar[XB_XCNT(j)]); sum += c; cnt += (c > 0u) ? 1u : 0u; mine = (j == x) ? c : mine; }
        if (sum == G) break;
        __builtin_amdgcn_s_sleep(1);
        if ((++sp & 255u) == 0u) { if (xb_ld(&bar[XB_TMO])) break; if (sp > XB_SPIN_CAP) { atomicAdd(&bar[XB_TMO], 1u); break; } }
    }
    nloc = mine > 0u ? mine : 1u; nx = cnt > 0u ? cnt : 1u;
}
DI void xcd_barrier(const XcdBarrier& b) {
    asm volatile("s_waitcnt vmcnt(0)" ::: "memory");
    __syncthreads();
    if (threadIdx.x == 0) {
        unsigned* bar = b.bar;
        __builtin_amdgcn_s_waitcnt(0);
        unsigned nloc = b.st[0], nx = b.st[1];
        if (nloc == 0u) { xcd_barrier_complete(bar, b.x, nloc, nx); b.st[0] = nloc; b.st[1] = nx; }
        const unsigned old = xb_add(&bar[XB_XSUB(b.x)], 1u);
        const unsigned gen = old / nloc;
        if (old + 1u == (gen + 1u) * nloc) {
            __builtin_amdgcn_fence(__ATOMIC_RELEASE, "agent");
            asm volatile("s_waitcnt vmcnt(0)" ::: "memory");
            const unsigned og = xb_add(&bar[XB_TOP], 1u);
            const unsigned tg = og / nx;
            if (og + 1u == (tg + 1u) * nx) xb_add(&bar[XB_TOPGEN], 1u);
            else XB_SPIN(xb_ld(&bar[XB_TOPGEN]) == tg, bar);
            __builtin_amdgcn_fence(__ATOMIC_ACQUIRE, "agent");
            xb_add(&bar[XB_XGEN(b.x)], 1u);
            asm volatile("s_waitcnt vmcnt(0)" ::: "memory");
        } else {
            XB_SPIN(xb_ld(&bar[XB_XGEN(b.x)]) == gen, bar);
            __builtin_amdgcn_fence(__ATOMIC_ACQUIRE, "agent");
            asm volatile("s_waitcnt vmcnt(0)" ::: "memory");
        }
    }
    __syncthreads();
}

namespace pg8 {
constexpr int BK = 64, HALF = 128, HTB = HALF * BK * 2, STAGE_BYTES = 8 * HTB;
DI int lds_byte(int r, int c) { const int st = (r >> 4) * 2 + (c >> 5), rr = r & 15, cc = c & 31, ob = rr * 64 + cc * 2; return st * 1024 + (ob ^ (((ob >> 9) & 1) << 5)); }
DI void stage_rc(int b, int& R, int& C) { const int st = b / 1024, sb = b % 1024, swz = sb ^ (((sb >> 9) & 1) << 5); R = (st >> 1) * 16 + swz / 64; C = (st & 1) * 32 + (swz % 64) / 2; }
struct GUnit { unsigned A, B; int pm, pn, e; };

template <class Epi, class Sched, bool PERM, bool FP8 = false, bool GATHER = false>
DI void gemm_phase(LAS unsigned char* lds, const unsigned char* wsb, const unsigned lda, const unsigned ldb, const int nt, const Sched& S, const Epi& E) {
    int tid = threadIdx.x; asm volatile("" : "+v"(tid));
    const int wid = __builtin_amdgcn_readfirstlane(tid >> 6), lane = tid & 63, wr = wid >> 2, wc = wid & 3, fr = lane & 15, fq = lane >> 4;
    unsigned voffA[2], voffB[2];
#pragma unroll
    for (int i = 0; i < 2; ++i) { int R, C; stage_rc(tid * 16 + i * 8192, R, C); const int Rb = PERM ? ((R & ~31) + perm32(R & 31)) : R;
        voffA[i] = (unsigned)R * lda + (unsigned)C * 2u; voffB[i] = (unsigned)Rb * ldb + (unsigned)C * 2u; }
    const unsigned kstep = (unsigned)(BK * 2);
    const unsigned hstepA = (unsigned)HALF * lda, hstepB = (unsigned)HALF * ldb;
    unsigned offC[2][2];
#pragma unroll
    for (int i = 0; i < 2; ++i) offC[0][i] = offC[1][i] = 0u;
    const int* tokl = (const int*)(wsb + WS_TOKL);
    LAS int* tokt = (LAS int*)(lds + LDS_TOKT);
    const unsigned ldsw = (unsigned)wid * 1024u;
    const LAS unsigned char* pa = lds + lds_byte(wr * 64 + fr, fq * 8); const LAS unsigned char* pb = lds + 4 * HTB + lds_byte(wc * 32 + fr, fq * 8);
    asm volatile("" : "+v"(pa), "+v"(pb));
#define PG8_SA(b, h) (((b) * 2 + (h)) * HTB)
#define PG8_SB(b, h) ((4 + (b) * 2 + (h)) * HTB)
#define PG8_STAGE(bufoff, gbase, voff) do { _Pragma("unroll") for (int _i = 0; _i < 2; ++_i) \
        __builtin_amdgcn_global_load_lds((const unsigned*)(wsb + (size_t)(gbase) + (voff)[_i]), (LAS unsigned*)(lds + (bufoff) + ldsw + _i * 8192), 16, 0, 0); } while (0)
#define PG8_STAGEA(bufoff, kt, h, nx) do { if constexpr (GATHER) { _Pragma("unroll") for (int _i = 0; _i < 2; ++_i) \
        __builtin_amdgcn_global_load_lds((const unsigned*)(wsb + WS_H8 + (size_t)((unsigned)(kt) * kstep) + offC[h][_i]), (LAS unsigned*)(lds + (bufoff) + ldsw + _i * 8192), 16, 0, 0); } \
        else PG8_STAGE(bufoff, ((nx) ? nA : cA) + (unsigned)(kt) * kstep + (unsigned)(h) * hstepA, voffA); } while (0)
#define PG8_LD8(p, off) __builtin_shufflevector(*(const LAS v4i*)((p) + (off)), *(const LAS v4i*)((p) + (off) + 1024), 0, 1, 2, 3, 4, 5, 6, 7)
#define PG8_LDA(dst, b, h) do { _Pragma("unroll") for (int m = 0; m < 4; ++m) { if constexpr (FP8) dst##8[m] = PG8_LD8(pa, PG8_SA(b, h) + m * 2048); \
        else { _Pragma("unroll") for (int k = 0; k < 2; ++k) dst[m][k] = *(const LAS bf16x8*)(pa + PG8_SA(b, h) + m * 2048 + k * 1024); } } } while (0)
#define PG8_LDB(dst, b, h) do { _Pragma("unroll") for (int n = 0; n < 2; ++n) { if constexpr (FP8) dst##8[n] = PG8_LD8(pb, PG8_SA(b, h) + n * 2048); \
        else { _Pragma("unroll") for (int k = 0; k < 2; ++k) dst[n][k] = *(const LAS bf16x8*)(pb + PG8_SA(b, h) + n * 2048 + k * 1024); } } } while (0)
#define PG8_CAT(x) __builtin_shufflevector(__builtin_bit_cast(v4i, (x)[0]), __builtin_bit_cast(v4i, (x)[1]), 0, 1, 2, 3, 4, 5, 6, 7)
#define PG8_MMA(ai, bj, At, Bt) do { __builtin_amdgcn_s_setprio(1); _Pragma("unroll") for (int m = 0; m < 4; ++m) _Pragma("unroll") for (int n = 0; n < 2; ++n) { \
        if constexpr (FP8) acc[ai][bj][m][n] = __builtin_amdgcn_mfma_scale_f32_16x16x128_f8f6f4(Bt##8[n], At##8[m], acc[ai][bj][m][n], 0, 0, 0, 0, 0, 0); \
        else { _Pragma("unroll") for (int k = 0; k < 2; ++k) acc[ai][bj][m][n] = __builtin_amdgcn_mfma_f32_16x16x32_bf16(Bt[n][k], At[m][k], acc[ai][bj][m][n], 0, 0, 0); } } \
        __builtin_amdgcn_s_setprio(0); } while (0)
#define PG8_WAIT_V(n) asm volatile("s_waitcnt vmcnt(" #n ")" ::: "memory")
#define PG8_WAIT_L(n) asm volatile("s_waitcnt lgkmcnt(" #n ")" ::: "memory")
#define PG8_BAR __builtin_amdgcn_s_barrier()
#define PG8_SCHED __builtin_amdgcn_sched_barrier(0)
    GUnit cur, nxt; int ui = 0;
    if (!S.next(0, cur)) return;
    f32x4 acc[2][2][4][2];
#pragma unroll
    for (int a = 0; a < 2; ++a)
#pragma unroll
        for (int b = 0; b < 2; ++b)
#pragma unroll
            for (int m = 0; m < 4; ++m)
#pragma unroll
                for (int n = 0; n < 2; ++n) acc[a][b][m][n] = (f32x4){0.f, 0.f, 0.f, 0.f};
    bf16x8 At[4][2], B0[2][2], B1[2][2]; v8i At8[4], B08[2], B18[2];
    unsigned cA = cur.A, cB = cur.B, nA = cur.A, nB = cur.B;
    if constexpr (GATHER) {
#pragma unroll
        for (int i = 0; i < 2; ++i) { int R, C; stage_rc(tid * 16 + i * 8192, R, C);
#pragma unroll
            for (int h = 0; h < 2; ++h) { const unsigned tk = (unsigned)tokl[cur.A + h * HALF + R]; offC[h][i] = (tk < (unsigned)NTOK ? tk : (unsigned)(NTOK - 1)) * lda + (unsigned)C * 2u; } }
        asm volatile("" : "+v"(offC[0][0]), "+v"(offC[0][1]), "+v"(offC[1][0]), "+v"(offC[1][1]));
    }
    PG8_STAGE(PG8_SB(0, 0), cB, voffB); PG8_STAGE(PG8_SB(0, 1), cB + hstepB, voffB); PG8_STAGEA(PG8_SA(0, 0), 0, 0, false); PG8_STAGEA(PG8_SA(0, 1), 0, 1, false);
    if (wr == 1) PG8_BAR;
    PG8_WAIT_V(2); PG8_BAR;
    PG8_STAGE(PG8_SB(1, 0), cB + kstep, voffB); PG8_STAGEA(PG8_SA(1, 0), 1, 0, false); PG8_STAGE(PG8_SB(1, 1), cB + hstepB + kstep, voffB);
    PG8_WAIT_V(6); PG8_BAR;
    for (;;) {
        const bool has_next = S.next(ui + 1, nxt);
        nA = has_next ? nxt.A : cA; nB = has_next ? nxt.B : cB;
        if constexpr (GATHER) {
            if (wid < 4) __builtin_amdgcn_global_load_lds((const unsigned*)(tokl + nA + tid), (LAS unsigned*)(tokt + wid * 64), 4, 0, 0);
        }
#pragma nounroll
        for (int t = 0; t < nt; t += 2) {
            const bool last = (t == nt - 2);
            const unsigned b2 = last ? nB : cB + (unsigned)(t + 2) * kstep, b3 = b2 + kstep;
            const int k2 = last ? 0 : t + 2, k3 = k2 + 1;
            PG8_LDB(B0, 0, 0); PG8_LDB(B1, 0, 1); PG8_SCHED; PG8_LDA(At, 0, 0); PG8_STAGEA(PG8_SA(1, 1), t + 1, 1, false);
            if constexpr (GATHER) { if (last) {
                int tz = tid; asm volatile("" : "+v"(tz));
#pragma unroll
                for (int i = 0; i < 2; ++i) { int R, C; stage_rc(tz * 16 + i * 8192, R, C);
#pragma unroll
                    for (int h = 0; h < 2; ++h) { const unsigned tk = (unsigned)tokt[h * HALF + R]; offC[h][i] = (tk < (unsigned)NTOK ? tk : (unsigned)(NTOK - 1)) * lda + (unsigned)C * 2u; } } } }
            PG8_WAIT_V(8); PG8_WAIT_L(0); PG8_BAR; PG8_MMA(0, 0, At, B0); PG8_MMA(0, 1, At, B1); PG8_BAR; PG8_SCHED;
            PG8_LDA(At, 0, 1); PG8_STAGE(PG8_SB(0, 0), b2, voffB); PG8_STAGE(PG8_SB(0, 1), b2 + hstepB, voffB); PG8_STAGEA(PG8_SA(0, 0), k2, 0, last);
            PG8_WAIT_V(8); PG8_WAIT_L(0); PG8_BAR; PG8_MMA(1, 0, At, B0); PG8_MMA(1, 1, At, B1); PG8_BAR; PG8_SCHED;
            PG8_LDB(B0, 1, 0); PG8_LDB(B1, 1, 1); PG8_SCHED; PG8_LDA(At, 1, 0); PG8_STAGEA(PG8_SA(0, 1), k2, 1, last);
            PG8_WAIT_V(8); PG8_WAIT_L(0); PG8_BAR; PG8_MMA(0, 0, At, B0); PG8_MMA(0, 1, At, B1); PG8_BAR; PG8_SCHED;
            PG8_LDA(At, 1, 1); PG8_STAGE(PG8_SB(1, 0), b3, voffB); PG8_STAGE(PG8_SB(1, 1), b3 + hstepB, voffB); PG8_STAGEA(PG8_SA(1, 0), k3, 0, last);
            PG8_WAIT_V(8); PG8_WAIT_L(0); PG8_BAR; PG8_MMA(1, 0, At, B0); PG8_MMA(1, 1, At, B1); PG8_BAR; PG8_SCHED;
        }

        if (wr == 0) PG8_BAR;
        E(acc, cur, wsb, wr, wc, fr, fq);
        if (!has_next) break;
#pragma unroll
        for (int a = 0; a < 2; ++a)
#pragma unroll
            for (int b = 0; b < 2; ++b)
#pragma unroll
                for (int m = 0; m < 4; ++m)
#pragma unroll
                    for (int n = 0; n < 2; ++n) acc[a][b][m][n] = (f32x4){0.f, 0.f, 0.f, 0.f};
        cur = nxt; cA = nA; cB = nB; ++ui;
        if (wr == 1) PG8_BAR;
    }
    PG8_WAIT_V(0);
    PG8_BAR;
#undef PG8_SA
#undef PG8_SB
#undef PG8_STAGE
#undef PG8_STAGEA
#undef PG8_LDA
#undef PG8_LD8
#undef PG8_LDB
#undef PG8_MMA
#undef PG8_CAT
#undef PG8_WAIT_V
#undef PG8_WAIT_L
#undef PG8_BAR
#undef PG8_SCHED
}
}
using pg8::GUnit;
typedef f32x4 AccT[2][2][4][2];

constexpr float C2A = LOG2E * 0.125f;
constexpr float C2D = LOG2E * 0.17677669529663687f;

DI void store8(bf16_t* p, f32x4 a) { u32x2 w; w.x = pk2(a[0], a[1]); w.y = pk2(a[2], a[3]); *(u32x2*)p = w; }
DI void store16(bf16_t* p, f32x4 a, f32x4 b) { u32x4 w; w.x = pk2(a[0], a[1]); w.y = pk2(a[2], a[3]); w.z = pk2(b[0], b[1]); w.w = pk2(b[2], b[3]); *(u32x4*)p = w; }
#define EPI_ARGS const AccT& acc, const GUnit& u, const unsigned char* wsb, int wr, int wc, int fr, int fq
#define EPI_OPAQUE() asm volatile("" : "+v"(fr), "+v"(fq))
#define WSB(T, off) ((T*)(const_cast<unsigned char*>(wsb) + (off)))

struct EpiProjTok {
    int li; LAS const float* rope;
    DI void head64(const AccT& acc, int rbase, int wc, int fq, bf16_t* dst, int pitch, const float* gain, float scale) const {
        LAS const float* cs16 = rope; LAS const float* sn16 = rope + 65 * 16;
        f32x4 g[2][2];
#pragma unroll
        for (int bj = 0; bj < 2; ++bj)
#pragma unroll
            for (int n = 0; n < 2; ++n) g[bj][n] = *(const f32x4*)(gain + 32 * bj + 16 * n + 4 * fq);
#pragma unroll
        for (int ai = 0; ai < 2; ++ai)
#pragma unroll
            for (int m = 0; m < 4; ++m) {
                const int row = rbase + 128 * ai + 16 * m;
                float ss = 0.f;
#pragma unroll
                for (int bj = 0; bj < 2; ++bj)
#pragma unroll
                    for (int n = 0; n < 2; ++n)
#pragma unroll
                        for (int i = 0; i < 4; ++i) ss += acc[ai][bj][m][n][i] * acc[ai][bj][m][n][i];
                ss = sum_x16_x32(ss);
                const float rinv = __builtin_amdgcn_rsqf(ss * (1.0f / 64.0f) + EPS) * scale;
                const bool lat = row < NLAT; const int t = row & (SEQ - 1);
#pragma unroll
                for (int bj = 0; bj < 2; ++bj) {
                    const f32x4 x1 = acc[ai][bj][m][0] * rinv * g[bj][0], x2 = acc[ai][bj][m][1] * rinv * g[bj][1];
                    const int pos = lat ? (bj ? (t & 63) : (t >> 6)) : 64;
                    const f32x4 c = *(LAS const f32x4*)(cs16 + pos * 16 + 4 * fq), sn = *(LAS const f32x4*)(sn16 + pos * 16 + 4 * fq);
                    bf16_t* p = dst + (size_t)row * pitch + wc * 64 + 32 * bj + 4 * fq;
                    store8(p, x1 * c - x2 * sn); store8(p + 16, x1 * sn + x2 * c);
                }
            }
    }
    DI void head32x2(const AccT& acc, int rbase, int wc, int fq, bf16_t* dst, const float* gain, float scale) const {
        LAS const float* cs8 = rope + 2 * 65 * 16; LAS const float* sn8 = cs8 + 65 * 8;
        const int dbase = 16 * (fq >> 1) + 4 * (fq & 1);
        const f32x4 g0 = *(const f32x4*)(gain + dbase), g1 = *(const f32x4*)(gain + dbase + 8);
#pragma unroll
        for (int ai = 0; ai < 2; ++ai)
#pragma unroll
            for (int m = 0; m < 4; ++m) {
                const int row = rbase + 128 * ai + 16 * m;
                const bool lat = row < NLAT; const int t = row & (SEQ - 1);
                const int pos = lat ? ((fq >> 1) ? (t & 63) : (t >> 6)) : 64;
                const f32x4 c = *(LAS const f32x4*)(cs8 + pos * 8 + 4 * (fq & 1)), sn = *(LAS const f32x4*)(sn8 + pos * 8 + 4 * (fq & 1));
#pragma unroll
                for (int bj = 0; bj < 2; ++bj) {
                    float ss = 0.f;
#pragma unroll
                    for (int n = 0; n < 2; ++n)
#pragma unroll
                        for (int i = 0; i < 4; ++i) ss += acc[ai][bj][m][n][i] * acc[ai][bj][m][n][i];
                    ss = sum_x16_x32(ss);
                    const float rinv = __builtin_amdgcn_rsqf(ss * (1.0f / 32.0f) + EPS) * scale;
                    const f32x4 x1 = acc[ai][bj][m][0] * rinv * g0, x2 = acc[ai][bj][m][1] * rinv * g1;
                    bf16_t* p = dst + (size_t)row * 256 + wc * 64 + 32 * bj + dbase;
                    store8(p, x1 * c - x2 * sn); store8(p + 8, x1 * sn + x2 * c);
                }
            }
    }
    DI void plain(const AccT& acc, int rbase, int wc, int fq, bf16_t* dst) const {
#pragma unroll
        for (int ai = 0; ai < 2; ++ai)
#pragma unroll
            for (int m = 0; m < 4; ++m) {
                const int row = rbase + 128 * ai + 16 * m;
#pragma unroll
                for (int bj = 0; bj < 2; ++bj) store16(dst + (size_t)row * 256 + 128 * bj + 32 * wc + 8 * fq, acc[ai][bj][m][0], acc[ai][bj][m][1]);
            }
    }
    DI void vtrans(const AccT& acc, int rbase, int kvh, int fq, bf16_t* VTA) const {
#pragma unroll
        for (int ai = 0; ai < 2; ++ai)
#pragma unroll
            for (int m = 0; m < 4; ++m) {
                const int row = rbase + 128 * ai + 16 * m; const bool lat = row < NLAT;
                const int b = lat ? (row >> 12) : ((row - NLAT) >> 8), key = lat ? (row & (SEQ - 1)) : SEQ + ((row - NLAT) & (CTX - 1));
                bf16_t* p = VTA + ((size_t)(b * 2 + kvh) * 64 + 8 * fq) * KEYS + key;
#pragma unroll
                for (int bj = 0; bj < 2; ++bj)
#pragma unroll
                    for (int n = 0; n < 2; ++n)
#pragma unroll
                        for (int i = 0; i < 4; ++i) p[(size_t)(32 * bj + 4 * n + i) * KEYS] = (bf16_t)(pk2(acc[ai][bj][m][n][i], 0.f) & 0xffffu);
            }
    }
    DI void operator()(EPI_ARGS) const {
        EPI_OPAQUE();
        const int rbase = u.pm * 256 + wr * 64 + fr;
        if (u.pn == 0) head64(acc, rbase, wc, fq, WSB(bf16_t, WS_QA), 256, kparams()->a_qg + li * 64, C2A);
        else if (u.pn == 1) { if (wc < 2) head64(acc, rbase, wc, fq, WSB(bf16_t, WS_KA), 128, kparams()->a_kg + li * 64, 1.0f); else vtrans(acc, rbase, wc - 2, fq, WSB(bf16_t, WS_VTA)); }
        else if (u.pn == 2) plain(acc, rbase, wc, fq, WSB(bf16_t, WS_BU));
        else if (u.pn == 3) plain(acc, rbase, wc, fq, WSB(bf16_t, WS_BG));
        else if (u.pn == 4) head32x2(acc, rbase, wc, fq, WSB(bf16_t, WS_QD), kparams()->d_qg + li * 32, C2D);
        else head32x2(acc, rbase, wc, fq, WSB(bf16_t, WS_KD), kparams()->d_kg + li * 32, 1.0f);
    }
};
struct SchedProjTok {
    unsigned woff; int G, c; bool last;
    DI bool next(int i, GUnit& u) const { const int L = i * G + c; if (L >= (last ? 128 * 6 + 16 : NTILE_TOK * 6)) return false;
        if (L < 128 * 6 || !last) { u.pm = L / 6; u.pn = L % 6; } else { const int j = L - 128 * 6; u.pm = 128 + (j >> 1); u.pn = (j & 1) ? 5 : 1; }
        u.e = 0; u.A = (unsigned)WS_H + (unsigned)u.pm * (256u * 2048u); u.B = woff + (unsigned)u.pn * (256u * 2048u); return true; }
};

struct EpiProjCh {
    DI void operator()(EPI_ARGS) const {
        EPI_OPAQUE();
        const bool ctx = u.pn >= 128; const int b = ctx ? (u.pn - 128) : (u.pn >> 4); const int t0 = ctx ? 0 : (u.pn & 15) * 256;
        bf16_t* base; size_t pitch; int tokoff;
        if (u.pm == 0) { base = WSB(bf16_t, WS_VTD) + (size_t)b * 4 * 64 * KEYS; pitch = KEYS; tokoff = ctx ? SEQ : t0; }
        else if (!ctx) { base = WSB(bf16_t, WS_FT) + (size_t)b * 256 * 8192; pitch = 8192; tokoff = t0 + (u.pm == 2 ? 4096 : 0); }
        else { base = WSB(bf16_t, WS_FTC) + (size_t)b * 256 * 512; pitch = 512; tokoff = (u.pm == 2 ? 256 : 0); }
#pragma unroll
        for (int ai = 0; ai < 2; ++ai) {
#pragma unroll
            for (int m = 0; m < 4; ++m) {
                const int lrow = 128 * ai + 64 * wr + 16 * m + fr;
#pragma unroll
                for (int bj = 0; bj < 2; ++bj) store16(base + (size_t)lrow * pitch + tokoff + 128 * bj + 32 * wc + 8 * fq, acc[ai][bj][m][0], acc[ai][bj][m][1]);
            }
        }
    }
};
struct SchedProjCh {
    unsigned woff; int G, c; bool last;
    DI bool next(int i, GUnit& u) const { const int L = i * G + c; if (L >= (last ? 128 * 3 + 8 : NTILE_TOK * 3)) return false;
        if (L < 128 * 3 || !last) { u.pn = L / 3; u.pm = L % 3; } else { const int j = L - 128 * 3; u.pn = 128 + j; u.pm = 0; }
        u.e = 0; u.A = woff + (unsigned)u.pm * (256u * 2048u); u.B = (unsigned)WS_H + (unsigned)u.pn * (256u * 2048u); return true; }
};

struct EpiFourier {
    DI void operator()(EPI_ARGS) const {
        EPI_OPAQUE();
        bf16_t* CAT = WSB(bf16_t, WS_CAT);
        const int rbase = u.e + wr * 64 + fr;
#pragma unroll
        for (int ai = 0; ai < 2; ++ai)
#pragma unroll
            for (int m = 0; m < 4; ++m) {
                const int row = rbase + 128 * ai + 16 * m;
#pragma unroll
                for (int bj = 0; bj < 2; ++bj) store16(CAT + (size_t)row * 1024 + 512 + 128 * bj + 32 * wc + 8 * fq, acc[ai][bj][m][0], acc[ai][bj][m][1]);
            }
    }
};
struct SchedFourLat {
    int G, c;
    DI bool next(int i, GUnit& u) const { const int L = i * G + c; if (L >= 128) return false;
        const int b = L >> 4, mt = L & 15; u.pm = mt; u.pn = 0; u.e = b * SEQ + mt * 256; u.A = (unsigned)WS_TL + (unsigned)mt * (256u * 16384u); u.B = (unsigned)WS_FT + (unsigned)b * (256u * 16384u); return true; }
};
struct SchedFourCtx {
    int G, c;
    DI bool next(int i, GUnit& u) const { const int L = i * G + c; if (L >= 8) return false;
        u.pm = 0; u.pn = 0; u.e = NLAT + L * CTX; u.A = (unsigned)WS_TC; u.B = (unsigned)WS_FTC + (unsigned)L * (256u * 1024u); return true; }
};

struct EpiOut {
    int li;
    DI void operator()(EPI_ARGS) const {
        EPI_OPAQUE();
        const float* mod = WSB(const float, WS_MOD) + (size_t)li * 9 * 6144; bf16_t* X1 = WSB(bf16_t, WS_X1);
        const int rbase = u.pm * 256 + wr * 64 + fr, cbase = u.pn * 256 + 64 * wc + 16 * fq;
        const int b9 = (u.pm < 128) ? (u.pm >> 4) : 8;
        f32x4 g[2][2];
#pragma unroll
        for (int bj = 0; bj < 2; ++bj)
#pragma unroll
            for (int n = 0; n < 2; ++n) g[bj][n] = *(const f32x4*)(mod + b9 * 6144 + 2048 + cbase + 8 * bj + 4 * n);
        if (li == 0) {
            KParamsPtr kp = kparams(); const float* xb = (u.pm < 128) ? kp->x : kp->ctx - (size_t)NLAT * 1024;
#pragma unroll
            for (int ai = 0; ai < 2; ++ai) {
                f32x4 xv[4][2][2];
#pragma unroll
                for (int m = 0; m < 4; ++m)
#pragma unroll
                    for (int bj = 0; bj < 2; ++bj)
#pragma unroll
                        for (int n = 0; n < 2; ++n) xv[m][bj][n] = *(const f32x4*)(xb + (size_t)(rbase + 128 * ai + 16 * m) * 1024 + cbase + 8 * bj + 4 * n);
#pragma unroll
                for (int m = 0; m < 4; ++m)
#pragma unroll
                    for (int bj = 0; bj < 2; ++bj) store16(X1 + (size_t)(rbase + 128 * ai + 16 * m) * 1024 + cbase + 8 * bj, xv[m][bj][0] + g[bj][0] * acc[ai][bj][m][0], xv[m][bj][1] + g[bj][1] * acc[ai][bj][m][1]);
            }
        } else {
            const bf16_t* X2 = WSB(const bf16_t, WS_X2);
            u32x4 xv[2][4][2];
#pragma unroll
            for (int ai = 0; ai < 2; ++ai)
#pragma unroll
                for (int m = 0; m < 4; ++m)
#pragma unroll
                    for (int bj = 0; bj < 2; ++bj) xv[ai][m][bj] = *(const u32x4*)(X2 + (size_t)(rbase + 128 * ai + 16 * m) * 1024 + cbase + 8 * bj);
#pragma unroll
            for (int ai = 0; ai < 2; ++ai)
#pragma unroll
                for (int m = 0; m < 4; ++m)
#pragma unroll
                    for (int bj = 0; bj < 2; ++bj) { const u32x4 xi = xv[ai][m][bj];
                        store16(X1 + (size_t)(rbase + 128 * ai + 16 * m) * 1024 + cbase + 8 * bj,
                                (f32x4){bflo(xi.x), bfhi(xi.x), bflo(xi.y), bfhi(xi.y)} + g[bj][0] * acc[ai][bj][m][0], (f32x4){bflo(xi.z), bfhi(xi.z), bflo(xi.w), bfhi(xi.w)} + g[bj][1] * acc[ai][bj][m][1]); }
        }
    }
};
struct SchedOut {
    unsigned woff; int G, c, npanel;
    DI bool next(int i, GUnit& u) const { const int L = i * G + c; if (L >= npanel * 4) return false;
        u.pm = L / 4; u.pn = L % 4; u.e = 0; u.A = (unsigned)WS_CAT + (unsigned)u.pm * (256u * 2048u); u.B = woff + (unsigned)u.pn * (256u * 2048u); return true; }
};

struct EpiMoe1 {
    int li;
    DI void operator()(EPI_ARGS) const {
        EPI_OPAQUE();
        unsigned char* ACT = WSB(unsigned char, WS_ACT);
        const int rbase = u.pm * 256 + wr * 64 + fr, cbase = u.pn * 128 + 32 * wc + 8 * fq;
        const float* bb = kparams()->b_gu + ((size_t)li * NE + u.e) * 2048 + cbase;
        f32x4 bg[2], bu1[2];
#pragma unroll
        for (int n = 0; n < 2; ++n) { bg[n] = *(const f32x4*)(bb + 4 * n); bu1[n] = *(const f32x4*)(bb + 1024 + 4 * n) + 1.0f; }
#pragma unroll
        for (int ai = 0; ai < 2; ++ai)
#pragma unroll
            for (int m = 0; m < 4; ++m) {
                const int row = rbase + 128 * ai + 16 * m;
                f32x4 o[2];
#pragma unroll
                for (int n = 0; n < 2; ++n) {
                    const f32x4 gg = acc[ai][0][m][n] * W8_INV + bg[n], uu = acc[ai][1][m][n] * W8_INV + bu1[n];
                    f32x4 gv, u1, e;
#pragma unroll
                    for (int i = 0; i < 4; ++i) { gv[i] = fminf(gg[i], 7.0f); u1[i] = __builtin_amdgcn_fmed3f(uu[i], -6.0f, 8.0f); }
                    const f32x4 t = gv * (-1.702f * LOG2E);
#pragma unroll
                    for (int i = 0; i < 4; ++i) e[i] = __builtin_amdgcn_exp2f(t[i]);
                    const f32x4 d = e + 1.0f;
                    f32x4 r;
#pragma unroll
                    for (int i = 0; i < 4; ++i) r[i] = __builtin_amdgcn_rcpf(d[i]);
                    o[n] = gv * u1 * r;
                }
                u32x2 w; w.x = pk4_fp8(o[0][0], o[0][1], o[0][2], o[0][3]); w.y = pk4_fp8(o[1][0], o[1][1], o[1][2], o[1][3]);
                *(u32x2*)(ACT + (size_t)row * 1024 + cbase) = w;
            }
    }
};
struct EpiMoe2 {
    int li;
    DI void operator()(EPI_ARGS) const {
        EPI_OPAQUE();
        unsigned char* YB = WSB(unsigned char, WS_XP) + (size_t)MAXMT * 256 * 1024;
        const int rbase = u.pm * 256 + wr * 64 + fr, cbase = u.pn * 256 + 64 * wc + 16 * fq;
        const float* bb = kparams()->b_dn + ((size_t)li * NE + u.e) * 1024 + cbase;
        f32x4 bv[2][2];
#pragma unroll
        for (int bj = 0; bj < 2; ++bj)
#pragma unroll
            for (int n = 0; n < 2; ++n) bv[bj][n] = *(const f32x4*)(bb + 8 * bj + 4 * n);
#pragma unroll
        for (int ai = 0; ai < 2; ++ai)
#pragma unroll
            for (int m = 0; m < 4; ++m) {
                const int row = rbase + 128 * ai + 16 * m;
                u32x4 w;
#pragma unroll
                for (int bj = 0; bj < 2; ++bj)
#pragma unroll
                    for (int n = 0; n < 2; ++n) { const f32x4 a = acc[ai][bj][m][n] * W8_INV + bv[bj][n]; w[2 * bj + n] = pk4_fp8(clamp448(a[0]), clamp448(a[1]), clamp448(a[2]), clamp448(a[3])); }
                *(u32x4*)(YB + (size_t)row * 1024 + cbase) = w;
            }
    }
};
template <int nN, bool GATH = false> struct SchedMoe {
    unsigned aoff, woff, wstride_e; const LAS int* tab; int G, c;
    DI bool next(int i, GUnit& u) const { const int NT = __builtin_amdgcn_readfirstlane(tab[0]);
        if ((G & 7) == 0) { const int idx = i * (G >> 3) + (c >> 3), per = (NT + 7) >> 3, loc = idx / nN; u.pm = (c & 7) * per + loc; u.pn = idx % nN; if (loc >= per || u.pm >= NT) return false; }
        else { const int L = i * G + c; if (L >= NT * nN) return false; u.pm = L / nN; u.pn = L % nN; }
        u.e = __builtin_amdgcn_readfirstlane(tab[64 + u.pm]);
        u.A = GATH ? (unsigned)(u.e * NTOK + (u.pm * 256 - __builtin_amdgcn_readfirstlane(tab[32 + u.e]))) : aoff + (unsigned)u.pm * (256u * 1024u);
        u.B = woff + (unsigned)u.e * wstride_e + (unsigned)u.pn * (256u * 1024u); return true; }
};

DI int invperm32(int c);
DI int fwd_gu(int n);
DI int fwd_lane16(int c);
DI int fwd_dn(int n);
constexpr int AT_ROWB = 144;
constexpr int AT_VROWB = 136;
constexpr int AT_TILEB = 64 * AT_ROWB;
constexpr int AT_BUFB = AT_TILEB + 64 * AT_VROWB + 128;
struct AttnArgs {
    const bf16_t* q;
    const bf16_t* klat;
    const bf16_t* kctx;
    int kpitch;
    const bf16_t* vt;
    int t0, t1;
    bf16_t* out;
    float lam, oscale; const float* subg;
    int wl, wli;
};
constexpr int AT_NWT = 24;
constexpr int AT_WT = 55296;
DI f32x16 mfma32(bf16x8 a, bf16x8 b, f32x16 c) { return __builtin_amdgcn_mfma_f32_32x32x16_bf16(a, b, c, 0, 0, 0); }
DI bf16x8 packp(const f32x16& x, int s) { u32x4 p; p.x = pk2(x[8 * s], x[8 * s + 1]); p.y = pk2(x[8 * s + 2], x[8 * s + 3]); p.z = pk2(x[8 * s + 4], x[8 * s + 5]); p.w = pk2(x[8 * s + 6], x[8 * s + 7]); return __builtin_bit_cast(bf16x8, p); }

template <bool DIFF>
DI void attn_unit(unsigned char* lds, const AttnArgs& a) {
    int tid = threadIdx.x; asm volatile("" : "+v"(tid));
    const int lane = tid & 63, r = lane & 31, h = lane >> 5; const int wid = __builtin_amdgcn_readfirstlane(tid >> 6);
    bf16x8 qf[4];
    { const bf16_t* qp = a.q + (size_t)(wid * 32 + r) * 256 + 8 * h;
#pragma unroll
      for (int x = 0; x < 4; ++x) qf[x] = *(const bf16x8*)(qp + 16 * x); }
    const int lrow = tid >> 3, lch = tid & 7;
    const bf16_t* vsrc = a.vt + (size_t)lrow * KEYS + 8 * lch;
    const int ldst = lrow * AT_ROWB + lch * 16, ldstv = AT_TILEB + lrow * AT_VROWB + lch * 16;
    const int koff = r * AT_ROWB + 16 * h;
    const int voff = AT_TILEB + r * AT_VROWB + 8 * h;
    f32x16 o0[2], o1[2];
#pragma unroll
    for (int d = 0; d < 2; ++d) { o0[d] = (f32x16){}; o1[d] = (f32x16){}; }
    f32x4 l0 = {0.f, 0.f, 0.f, 0.f}, l1 = {0.f, 0.f, 0.f, 0.f};
    u32x4 kregA, vregA, kregB, vregB;
    auto gload = [&](int t, u32x4& kreg, u32x4& vreg) __attribute__((always_inline)) {
        const bf16_t* kp = (t < 64) ? a.klat + (size_t)(t * 64 + lrow) * a.kpitch : a.kctx + (size_t)((t - 64) * 64 + lrow) * a.kpitch;
        kreg = *(const u32x4*)(kp + 8 * lch);
        vreg = *(const u32x4*)(vsrc + (size_t)t * 64);
    };
    auto lstore = [&](int slot, const u32x4& kreg, const u32x4& vreg) __attribute__((always_inline)) { unsigned char* b = lds + slot * AT_BUFB; *(u32x4*)(b + ldst) = kreg; *(u32x2*)(b + ldstv) = (u32x2){vreg.x, vreg.y}; *(u32x2*)(b + ldstv + 8) = (u32x2){vreg.z, vreg.w}; };
    auto kread = [&](const unsigned char* Kb, int hh, bf16x8 (&kf)[4]) __attribute__((always_inline)) {
#pragma unroll
        for (int x = 0; x < 4; ++x) kf[x] = *(const bf16x8*)(Kb + koff + hh * 32 * AT_ROWB + 32 * x); };
    auto vread = [&](const unsigned char* Vb, int hh, bf16x8 (&vf)[2][2]) __attribute__((always_inline)) {
#pragma unroll
        for (int s2 = 0; s2 < 2; ++s2)
#pragma unroll
            for (int d = 0; d < 2; ++d) { const unsigned char* vp = Vb + voff + d * 32 * AT_VROWB + 64 * hh + 32 * s2;
                const s16x4 lo = *(const s16x4*)vp, hi = *(const s16x4*)(vp + 16); vf[s2][d] = __builtin_shufflevector(lo, hi, 0, 1, 2, 3, 4, 5, 6, 7); } };
    auto qk = [&](const bf16x8 (&kf)[4], f32x16& sa, f32x16& sb) __attribute__((always_inline)) {
        if (!DIFF) { sa = mfma32(kf[0], qf[0], (f32x16){}); sa = mfma32(kf[1], qf[1], sa); sa = mfma32(kf[2], qf[2], sa); sa = mfma32(kf[3], qf[3], sa); }
        else { sa = mfma32(kf[0], qf[0], (f32x16){}); sb = mfma32(kf[2], qf[2], (f32x16){}); sa = mfma32(kf[1], qf[1], sa); sb = mfma32(kf[3], qf[3], sb); }
    };
    auto expsum = [&](f32x16& sc, f32x4& l) __attribute__((always_inline)) {
#pragma unroll
        for (int i = 0; i < 16; ++i) sc[i] = __builtin_amdgcn_exp2f(sc[i]);
#pragma unroll
        for (int i = 0; i < 4; ++i) l += (f32x4){sc[4 * i], sc[4 * i + 1], sc[4 * i + 2], sc[4 * i + 3]};
    };
    auto pv1 = [&](const bf16x8 (&vf)[2][2], const f32x16& pa, f32x16 (&o)[2]) __attribute__((always_inline)) {
#pragma unroll
        for (int s2 = 0; s2 < 2; ++s2) { const bf16x8 pp = packp(pa, s2); o[0] = mfma32(vf[s2][0], pp, o[0]); o[1] = mfma32(vf[s2][1], pp, o[1]); }
    };
    f32x4 wq[4];
    const int wn4 = (tid & 63) * 4;
    constexpr int WPITCH = 36;
    auto w_decode = [&](int j, const float*& src, unsigned char*& dst, int& ld, int& n0, int& k0, bool& gu) __attribute__((always_inline)) {
        const int g = (j >> 2) * 512 + a.wl, e = g / 96, r = g - e * 96; KParamsPtr kp = kparams();
        if (r < 64) { src = kp->w_gu + ((size_t)a.wli * NE + e) * (1024 * 2048); dst = kp->ws + WS_WGU + (size_t)a.wli * SZ_WGU + (size_t)e * 2048 * 1024; ld = 2048; n0 = (r & 7) * 256; k0 = ((r >> 3) * 4 + (j & 3)) * 32; gu = true; }
        else { const int q = r - 64; src = kp->w_dn + ((size_t)a.wli * NE + e) * (1024 * 1024); dst = kp->ws + WS_WDN + (size_t)a.wli * SZ_WDN + (size_t)e * 1024 * 1024; ld = 1024; n0 = (q & 3) * 256; k0 = ((q >> 2) * 4 + (j & 3)) * 32; gu = false; } };
    auto w_issue = [&](int j) __attribute__((always_inline)) { const float* src; unsigned char* dst; int ld, n0, k0; bool gu; w_decode(j, src, dst, ld, n0, k0, gu);
        const float* p = src + (size_t)(k0 + 4 * wid) * ld + n0 + wn4;
        wq[0] = __builtin_nontemporal_load((const f32x4*)p); wq[1] = __builtin_nontemporal_load((const f32x4*)(p + ld));
        wq[2] = __builtin_nontemporal_load((const f32x4*)(p + (size_t)2 * ld)); wq[3] = __builtin_nontemporal_load((const f32x4*)(p + (size_t)3 * ld)); };
    auto w_cvt = [&]() __attribute__((always_inline)) { unsigned char* t8 = lds + AT_WT + wn4 * WPITCH + 4 * wid;
#pragma unroll
        for (int j = 0; j < 4; ++j) *(unsigned*)(t8 + j * WPITCH) = pk4_fp8(wq[0][j] * W8_SCALE, wq[1][j] * W8_SCALE, wq[2][j] * W8_SCALE, wq[3][j] * W8_SCALE); };
    auto w_store = [&](int j) __attribute__((always_inline)) { const float* src; unsigned char* dst; int ld, n0, k0; bool gu; w_decode(j, src, dst, ld, n0, k0, gu);
        const int col = tid >> 1, half = tid & 1, n = n0 + col; const int p = gu ? fwd_gu(n) : fwd_dn(n);
        const unsigned* t = (const unsigned*)(lds + AT_WT + col * WPITCH + 16 * half);
        *(u32x4*)(dst + (size_t)p * 1024 + k0 + 16 * half) = (u32x4){t[0], t[1], t[2], t[3]}; };
    const bool wrider = !DIFF && a.wl >= 0;
    if (wrider) w_issue(0);
    gload(a.t0, kregA, vregA); gload(a.t0 + 1 < a.t1 ? a.t0 + 1 : a.t0, kregB, vregB);
    lstore(0, kregA, vregA); lstore(1, kregB, vregB);
    __syncthreads();
    asm volatile("" : "+v"(qf[0]), "+v"(qf[1]), "+v"(qf[2]), "+v"(qf[3]));
    if (!DIFF && a.t0 + 2 < a.t1) gload(a.t0 + 2, kregA, vregA);
    f32x16 s0a, s0b, s1a, s1b; s0b = (f32x16){}; s1b = (f32x16){};
    bf16x8 kf[4], vf[2][2];
    kread(lds, 0, kf); qk(kf, s0a, s0b);
    int slot = 0;
    auto step = [&](int t, u32x4& kl, u32x4& vl, const u32x4& ks, const u32x4& vs, const int hk, const int wj) __attribute__((always_inline)) {
        const int slot1 = slot == 2 ? 0 : slot + 1, slot2 = slot1 == 2 ? 0 : slot1 + 1;
        if (!DIFF && hk == 1) { w_cvt(); w_issue(wj + 1 < AT_NWT ? wj + 1 : AT_NWT - 1); }
        if (!DIFF && hk == 2) w_store(wj);
        { const int tn = t + (DIFF ? 2 : 3); gload(tn < a.t1 ? tn : a.t1 - 1, kl, vl); }
        const unsigned char* Kb = lds + slot * AT_BUFB;
        if (!DIFF) {
            kread(Kb, 1, kf); vread(Kb, 0, vf);
            qk(kf, s1a, s1b);
            expsum(s0a, l0);
            pv1(vf, s0a, o0);
            kread(lds + slot1 * AT_BUFB, 0, kf);
            vread(Kb, 1, vf);
            qk(kf, s0a, s0b);
            expsum(s1a, l0);
            pv1(vf, s1a, o0);
        } else {
            kread(Kb, 1, kf); vread(Kb, 0, vf);
            qk(kf, s1a, s1b);
            expsum(s0a, l0); expsum(s0b, l1);
            pv1(vf, s0a, o0); pv1(vf, s0b, o1);
            kread(lds + slot1 * AT_BUFB, 0, kf);
            vread(Kb, 1, vf);
            qk(kf, s0a, s0b);
            expsum(s1a, l0); expsum(s1b, l1);
            pv1(vf, s1a, o0); pv1(vf, s1b, o1);
        }
        lstore(slot2, ks, vs);
        __syncthreads();
        slot = slot1;
    };
    if (DIFF) { for (int t = a.t0; t < a.t1; ++t) step(t, kregA, vregA, kregA, vregA, 0, 0); }
    else {
        int t = a.t0;
        if (wrider)
            for (int j = 0; j < AT_NWT; ++j, t += 2) { step(t, kregB, vregB, kregA, vregA, 1, j); step(t + 1, kregA, vregA, kregB, vregB, 2, j); }
        for (; t < a.t1; t += 2) {
            step(t, kregB, vregB, kregA, vregA, 0, 0);
            if (t + 1 < a.t1) step(t + 1, kregA, vregA, kregB, vregB, 0, 0);
        }
    }
    float lt0 = l0[0] + l0[1] + l0[2] + l0[3];
    lt0 += __shfl_xor(lt0, 32);
    bf16_t* op = a.out + (size_t)(wid * 32 + r) * 1024 + 4 * h;
    if (!DIFF) {
        const float rl = 1.0f / lt0;
#pragma unroll
        for (int d = 0; d < 2; ++d)
#pragma unroll
            for (int g = 0; g < 4; ++g) { f32x4 v = {o0[d][4 * g] * rl, o0[d][4 * g + 1] * rl, o0[d][4 * g + 2] * rl, o0[d][4 * g + 3] * rl}; store8(op + 32 * d + 8 * g, v); }
    } else {
        float lt1 = l1[0] + l1[1] + l1[2] + l1[3];
        lt1 += __shfl_xor(lt1, 32);
        const float r0 = 1.0f / lt0, r1 = a.lam / lt1;
        float ss = 0.f;
#pragma unroll
        for (int d = 0; d < 2; ++d)
#pragma unroll
            for (int i = 0; i < 16; ++i) { const float v = o0[d][i] * r0 - o1[d][i] * r1; o0[d][i] = v; ss += v * v; }
        ss += __shfl_xor(ss, 32);
        const float rinv = rsqrtf(ss * (1.0f / 64.0f) + EPS) * a.oscale;
        f32x4 ggv[2][4];
#pragma unroll
        for (int d = 0; d < 2; ++d)
#pragma unroll
            for (int g = 0; g < 4; ++g) ggv[d][g] = *(const f32x4*)(a.subg + 32 * d + 8 * g + 4 * h);
        asm volatile("" : "+v"(ggv[0][0]), "+v"(ggv[1][3]));
#pragma unroll
        for (int d = 0; d < 2; ++d)
#pragma unroll
            for (int g = 0; g < 4; ++g) { const f32x4 gg = ggv[d][g];
                f32x4 v = {o0[d][4 * g] * rinv * gg[0], o0[d][4 * g + 1] * rinv * gg[1], o0[d][4 * g + 2] * rinv * gg[2], o0[d][4 * g + 3] * rinv * gg[3]}; store8(op + 32 * d + 8 * g, v); }
    }
}

constexpr int FF_PITCH = 272;
constexpr int FF1_A = 0, FF1_B = 128 * FF_PITCH;
constexpr int FF3_A = 0, FF3_B = 64 * FF_PITCH;
DI void fft_load_a(unsigned char* lds, const bf16_t* M, int rows) {
    for (int idx = ld_tid(); idx < rows * 16; idx += 512) { const int r = idx >> 4, c = idx & 15; *(u32x4*)(lds + r * FF_PITCH + 16 * c) = *(const u32x4*)(M + r * 128 + 8 * c); }
    __syncthreads();
}
DI void fft1_unit(unsigned char* lds, const unsigned char* ws, int unit) {
    int tid = threadIdx.x; asm volatile("" : "+v"(tid));
    const int lane = tid & 63, r = lane & 31, h = lane >> 5, w = tid >> 6, b = unit >> 6, cq = unit & 63;
    const bf16_t* FT = (const bf16_t*)(ws + WS_FT) + (size_t)(b * 256 + 4 * cq) * 8192;
    unsigned char* Bt = lds + FF1_B;
    { u32x4 v[8];
#pragma unroll
      for (int j = 0; j < 8; ++j) { const int idx = tid + 512 * j, t2c = idx & 7, t1 = (idx >> 3) & 63, part = (idx >> 9) & 1, chl = idx >> 10;
          v[j] = *(const u32x4*)(FT + (size_t)chl * 8192 + part * 4096 + 64 * t1 + 8 * t2c); }
#pragma unroll
      for (int j = 0; j < 8; ++j) { const int idx = tid + 512 * j, t2c = idx & 7, t1 = (idx >> 3) & 63, part = (idx >> 9) & 1, chl = idx >> 10;
          unsigned char* d = Bt + (chl * 64 + 8 * t2c) * FF_PITCH + (part * 64 + t1) * 2;
#pragma unroll
          for (int e = 0; e < 4; ++e) { *(bf16_t*)(d + (2 * e) * FF_PITCH) = (bf16_t)(v[j][e] & 0xffffu); *(bf16_t*)(d + (2 * e + 1) * FF_PITCH) = (bf16_t)(v[j][e] >> 16); } } }
    __syncthreads();
    f32x16 acc[4];
#pragma unroll
    for (int rb = 0; rb < 4; ++rb) acc[rb] = (f32x16){};
#pragma unroll
    for (int ks = 0; ks < 8; ++ks) { const bf16x8 bf = *(const bf16x8*)(Bt + (32 * w + r) * FF_PITCH + 32 * ks + 16 * h);
#pragma unroll
        for (int rb = 0; rb < 4; ++rb) acc[rb] = mfma32(*(const bf16x8*)(lds + FF1_A + (32 * rb + r) * FF_PITCH + 32 * ks + 16 * h), bf, acc[rb]); }
    const int t2 = 32 * (w & 1) + r, ch = 4 * cq + (w >> 1);
    const float* TW = (const float*)(ws + WS_TW); bf16_t* Y2 = (bf16_t*)(const_cast<unsigned char*>(ws) + WS_Y2);
    f32x2 twv[2][16];
#pragma unroll
    for (int rb = 0; rb < 2; ++rb)
#pragma unroll
        for (int i = 0; i < 16; ++i) { const int k1 = 32 * rb + (i & 3) + 8 * (i >> 2) + 4 * h; twv[rb][i] = *(const f32x2*)(TW + 2 * (k1 * 64 + t2)); }
    asm volatile("" : "+v"(twv[0][0]), "+v"(twv[0][15]), "+v"(twv[1][0]), "+v"(twv[1][15]));
#pragma unroll
    for (int rb = 0; rb < 2; ++rb)
#pragma unroll
        for (int i = 0; i < 16; ++i) { const int k1 = 32 * rb + (i & 3) + 8 * (i >> 2) + 4 * h;
            const f32x2 tw = twv[rb][i]; const float re = acc[rb][i], im = acc[2 + rb][i];
            bf16_t* y = Y2 + ((size_t)((b * 64 + k1) * 256 + ch)) * 128 + t2;
            const unsigned pr = pk2(re * tw.x + im * tw.y, im * tw.x - re * tw.y);
            y[0] = (bf16_t)(pr & 0xffffu); y[64] = (bf16_t)(pr >> 16); }
    __syncthreads();
}
DI void fft3_unit(unsigned char* lds, const unsigned char* ws, int unit) {
    int tid = threadIdx.x; asm volatile("" : "+v"(tid));
    const int lane = tid & 63, r = lane & 31, h = lane >> 5, w = tid >> 6, b = unit >> 6, k1 = unit & 63;
    const bf16_t* Y2 = (const bf16_t*)(ws + WS_Y2) + (size_t)unit * 256 * 128;
    unsigned char* Bt = lds + FF3_B;
    { u32x4 v[8];
#pragma unroll
      for (int j = 0; j < 8; ++j) { const int idx = tid + 512 * j; v[j] = *(const u32x4*)(Y2 + (size_t)idx * 8); }
#pragma unroll
      for (int j = 0; j < 8; ++j) { const int idx = tid + 512 * j; *(u32x4*)(Bt + (idx >> 4) * FF_PITCH + 16 * (idx & 15)) = v[j]; } }
    __syncthreads();
    f32x16 acc[2];
    acc[0] = (f32x16){}; acc[1] = (f32x16){};
#pragma unroll
    for (int ks = 0; ks < 8; ++ks) { const bf16x8 bf = *(const bf16x8*)(Bt + (32 * w + r) * FF_PITCH + 32 * ks + 16 * h);
#pragma unroll
        for (int rb = 0; rb < 2; ++rb) acc[rb] = mfma32(*(const bf16x8*)(lds + FF3_A + (32 * rb + r) * FF_PITCH + 32 * ks + 16 * h), bf, acc[rb]); }
    bf16_t* CAT = (bf16_t*)(const_cast<unsigned char*>(ws) + WS_CAT) + (size_t)(b * SEQ + k1) * 1024 + 512 + 32 * w + r;
#pragma unroll
    for (int rb = 0; rb < 2; ++rb)
#pragma unroll
        for (int i = 0; i < 16; ++i) { const int k2 = 32 * rb + (i & 3) + 8 * (i >> 2) + 4 * h; CAT[(size_t)k2 * 64 * 1024] = (bf16_t)(pk2(acc[rb][i], 0.f) & 0xffffu); }
    __syncthreads();
}

DI void load_row(const float* xr, int lane, f32x4 (&v)[4]) {
    v[0] = *(const f32x4*)(xr + 8 * lane); v[1] = *(const f32x4*)(xr + 8 * lane + 4); v[2] = *(const f32x4*)(xr + 512 + 8 * lane); v[3] = *(const f32x4*)(xr + 512 + 8 * lane + 4);
}
DI void load_row_bf(const bf16_t* xr, int lane, f32x4 (&v)[4]) {
    const u32x4 a = *(const u32x4*)(xr + 8 * lane), b = *(const u32x4*)(xr + 512 + 8 * lane);
    v[0] = (f32x4){bflo(a[0]), bfhi(a[0]), bflo(a[1]), bfhi(a[1])}; v[1] = (f32x4){bflo(a[2]), bfhi(a[2]), bflo(a[3]), bfhi(a[3])};
    v[2] = (f32x4){bflo(b[0]), bfhi(b[0]), bflo(b[1]), bfhi(b[1])}; v[3] = (f32x4){bflo(b[2]), bfhi(b[2]), bflo(b[3]), bfhi(b[3])};
}
DI void modnorm_row(f32x4 (&v)[4], int lane, const float* g, const float* sh, const float* sc) {
    float ss = 0.f;
#pragma unroll
    for (int j = 0; j < 4; ++j)
#pragma unroll
        for (int i = 0; i < 4; ++i) ss += v[j][i] * v[j][i];
    ss = wave_sum(ss);
    const float rinv = rsqrtf(ss * (1.0f / 1024.0f) + EPS);
#pragma unroll
    for (int j = 0; j < 4; ++j) { const int k = (j >> 1) * 512 + 8 * lane + 4 * (j & 1);
        const f32x4 gg = *(const f32x4*)(g + k), s1 = *(const f32x4*)(sc + k), s0 = *(const f32x4*)(sh + k);
        v[j] = v[j] * rinv * gg * (s1 + 1.0f) + s0; }
}
DI void store_row_bf16(bf16_t* hr, int lane, const f32x4 (&v)[4]) { store16(hr + 8 * lane, v[0], v[1]); store16(hr + 512 + 8 * lane, v[2], v[3]); }

DI void phase_norm1(const Params& P, bf16_t* H, const float* mod0, int G) {
    const int tid_ = ld_tid(); const int lane = tid_ & 63, gw = blockIdx.x * 8 + (tid_ >> 6);
    for (int row = gw; row < NTOK; row += G * 8) {
        const float* xr = row < NLAT ? P.x + (size_t)row * 1024 : P.ctx + (size_t)(row - NLAT) * 1024;
        const float* md = mod0 + (row < NLAT ? (row >> 12) : 8) * 6144;
        f32x4 v[4]; load_row(xr, lane, v);
        modnorm_row(v, lane, P.norm1_g, md, md + 1024);
        store_row_bf16(H + (size_t)row * 1024, lane, v);
    }
}

DI void conv_unit(unsigned char* lds, int seqrow, int L, int t0, const bf16_t* BU, const bf16_t* BG, const float* cw, const float* cb, const float* lg, const float* lb, bf16_t* CAT) {
    float* z = (float*)lds;
    int tid = threadIdx.x; asm volatile("" : "+v"(tid));
    { u32x4 uv[6], gv[6];
#pragma unroll
      for (int q = 0; q < 6; ++q) { const int idx = tid + 512 * q, j = idx >> 5, c8 = (idx & 31) * 8, t = t0 - 15 + j; const bool ok = idx < 94 * 32 && t >= 0 && t < L;
          const size_t off = (size_t)(seqrow + (ok ? t : t0)) * 256 + c8; uv[q] = *(const u32x4*)(BU + off); gv[q] = *(const u32x4*)(BG + off); }
#pragma unroll
      for (int q = 0; q < 6; ++q) { const int idx = tid + 512 * q, j = idx >> 5, c8 = (idx & 31) * 8, t = t0 - 15 + j;
          if (idx < 94 * 32) { const bool ok = t >= 0 && t < L; float o[8];
#pragma unroll
              for (int e = 0; e < 4; ++e) { o[2 * e] = ok ? bflo(uv[q][e]) * sigmoidf_(bflo(gv[q][e])) : 0.f; o[2 * e + 1] = ok ? bfhi(uv[q][e]) * sigmoidf_(bfhi(gv[q][e])) : 0.f; }
              *(f32x4*)(z + j * 256 + c8) = (f32x4){o[0], o[1], o[2], o[3]}; *(f32x4*)(z + j * 256 + c8 + 4) = (f32x4){o[4], o[5], o[6], o[7]}; } } }
    __syncthreads();
    const int c = tid & 255, half = tid >> 8;
    float acc[32];
    { const float b = cb[c];
#pragma unroll
      for (int i = 0; i < 32; ++i) acc[i] = b; }
    { float wj[31], zr[62];
#pragma unroll
      for (int j = 0; j < 31; ++j) wj[j] = cw[j * 256 + c];
#pragma unroll
      for (int q = 0; q < 62; ++q) zr[q] = z[(32 * half + q) * 256 + c];
#pragma unroll
      for (int j = 0; j < 31; ++j)
#pragma unroll
          for (int i = 0; i < 32; ++i) acc[i] += wj[j] * zr[i + j]; }
    __syncthreads();
#pragma unroll
    for (int i = 0; i < 32; ++i) z[(32 * half + i) * 256 + c] = acc[i];
    __syncthreads();
    const int lane = tid & 63, wv = tid >> 6;
    const f32x4 g4 = *(const f32x4*)(lg + 4 * lane), b4 = *(const f32x4*)(lb + 4 * lane);
    for (int tt = wv; tt < 64; tt += 8) {
        const f32x4 v = *(const f32x4*)(z + tt * 256 + 4 * lane);
        const float mean = wave_sum(v[0] + v[1] + v[2] + v[3]) * (1.0f / 256.0f);
        const f32x4 d = v - mean;
        const float var = wave_sum(d[0] * d[0] + d[1] * d[1] + d[2] * d[2] + d[3] * d[3]) * (1.0f / 256.0f);
        const f32x4 y = d * rsqrtf(var + EPS) * g4 + b4;
        f32x4 o;
#pragma unroll
        for (int e = 0; e < 4; ++e) o[e] = y[e] * sigmoidf_(y[e]);
        store8(CAT + (size_t)(seqrow + t0 + tt) * 1024 + 256 + 4 * lane, o);
    }
    __syncthreads();
}

constexpr int RT_CH = 136;
constexpr int RT_HS = 0, RT_PART = 16 * 1028 * 4, RT_LOG = RT_PART + 8 * 16 * 32 * 4, RT_HIST = RT_LOG + 144 * 33 * 4, RT_BASE = RT_HIST + 128, RT_RE = RT_BASE + 128, RT_RP = RT_RE + RT_CH * 16, RT_RG = RT_RP + RT_CH * 16;
DI void phase_router(unsigned char* lds, const Params& P, int li, const bf16_t* X1, unsigned char* H8, const float* modl, unsigned* cnt, int* tok_e, int* tok_pos, float* tok_gate, int* tok_list, int G, int ntok, int chsz) {
    const int tid = ld_tid(), lane = tid & 63, w = tid >> 6;
    float* Hs = (float*)(lds + RT_HS); float* part = (float*)(lds + RT_PART); float* logit = (float*)(lds + RT_LOG);
    int* hist = (int*)(lds + RT_HIST); int* base = (int*)(lds + RT_BASE); int* rec_e = (int*)(lds + RT_RE); int* rec_p = (int*)(lds + RT_RP); float* rec_g = (float*)(lds + RT_RG);
    const float* rw = P.router_w + (size_t)li * 1024 * 32; const float* rb = P.router_b + li * 32; const float* g2n = P.norm2_g + li * 1024;
    float wreg[32][2];
#pragma unroll
    for (int s = 0; s < 32; ++s)
#pragma unroll
        for (int hf = 0; hf < 2; ++hf) wreg[s][hf] = rw[(size_t)(128 * w + 4 * s + (lane >> 4)) * 32 + 16 * hf + (lane & 15)];
    f32x4 ma[4], mb[4]; int cur_b9 = -1;
    auto load_mod = [&](int b9) __attribute__((always_inline)) { const float* md = modl + b9 * 6144;
#pragma unroll
        for (int j = 0; j < 4; ++j) { const int k = (j >> 1) * 512 + 8 * lane + 4 * (j & 1); ma[j] = *(const f32x4*)(g2n + k) * (*(const f32x4*)(md + 4 * 1024 + k) + 1.0f); mb[j] = *(const f32x4*)(md + 3 * 1024 + k); }
        cur_b9 = b9; };
    for (int ch = blockIdx.x; ch * chsz < ntok; ch += G) {
        const int c0 = ch * chsz, ngrp = (chsz + 15) / 16;
        if (tid < 32) hist[tid] = 0;
        u32x4 ra[2], rbv[2];
        auto fetch = [&](int g) __attribute__((always_inline)) {
#pragma unroll
            for (int rr = 0; rr < 2; ++rr) { const int tl = 16 * g + 2 * w + rr; const bf16_t* xr = X1 + (size_t)(c0 + (tl < chsz ? tl : 0)) * 1024;
                ra[rr] = *(const u32x4*)(xr + 8 * lane); rbv[rr] = *(const u32x4*)(xr + 512 + 8 * lane); } };
        fetch(0);
        __syncthreads();
        for (int g = 0; g < ngrp; ++g) {
#pragma unroll
            for (int rr = 0; rr < 2; ++rr) {
                const int tl = 16 * g + 2 * w + rr, tok = c0 + tl; float* hs = Hs + (2 * w + rr) * 1028;
                f32x4 v[4];
                if (tl < chsz) {
                    const u32x4 a = ra[rr], b = rbv[rr];
                    v[0] = (f32x4){bflo(a[0]), bfhi(a[0]), bflo(a[1]), bfhi(a[1])}; v[1] = (f32x4){bflo(a[2]), bfhi(a[2]), bflo(a[3]), bfhi(a[3])};
                    v[2] = (f32x4){bflo(b[0]), bfhi(b[0]), bflo(b[1]), bfhi(b[1])}; v[3] = (f32x4){bflo(b[2]), bfhi(b[2]), bflo(b[3]), bfhi(b[3])};
                    const int b9 = tok < NLAT ? (tok >> 12) : 8; if (b9 != cur_b9) load_mod(b9);
                    float ss = 0.f;
#pragma unroll
                    for (int j = 0; j < 4; ++j)
#pragma unroll
                        for (int i = 0; i < 4; ++i) ss += v[j][i] * v[j][i];
                    ss = wave_sum(ss);
                    const float rinv = __builtin_amdgcn_rsqf(ss * (1.0f / 1024.0f) + EPS);
#pragma unroll
                    for (int j = 0; j < 4; ++j) v[j] = v[j] * rinv * ma[j] + mb[j];
                    { unsigned char* hr = H8 + (size_t)tok * 1024; u32x2 w0, w1;
                      w0.x = pk4_fp8(clamp448(v[0][0]), clamp448(v[0][1]), clamp448(v[0][2]), clamp448(v[0][3])); w0.y = pk4_fp8(clamp448(v[1][0]), clamp448(v[1][1]), clamp448(v[1][2]), clamp448(v[1][3]));
                      w1.x = pk4_fp8(clamp448(v[2][0]), clamp448(v[2][1]), clamp448(v[2][2]), clamp448(v[2][3])); w1.y = pk4_fp8(clamp448(v[3][0]), clamp448(v[3][1]), clamp448(v[3][2]), clamp448(v[3][3]));
                      *(u32x2*)(hr + 8 * lane) = w0; *(u32x2*)(hr + 512 + 8 * lane) = w1; } }
                else {
#pragma unroll
                    for (int j = 0; j < 4; ++j) v[j] = (f32x4){0.f, 0.f, 0.f, 0.f}; }
                *(f32x4*)(hs + 8 * lane) = v[0]; *(f32x4*)(hs + 8 * lane + 4) = v[1]; *(f32x4*)(hs + 512 + 8 * lane) = v[2]; *(f32x4*)(hs + 512 + 8 * lane + 4) = v[3];
            }
            if (g + 1 < ngrp) fetch(g + 1);
            __syncthreads();
            f32x4 a0 = {0.f, 0.f, 0.f, 0.f}, a1 = {0.f, 0.f, 0.f, 0.f};
            { const float* hp = Hs + (lane & 15) * 1028 + 128 * w + (lane >> 4);
#pragma unroll
              for (int s = 0; s < 32; ++s) { const float av = hp[4 * s];
                  a0 = __builtin_amdgcn_mfma_f32_16x16x4f32(av, wreg[s][0], a0, 0, 0, 0); a1 = __builtin_amdgcn_mfma_f32_16x16x4f32(av, wreg[s][1], a1, 0, 0, 0); } }
#pragma unroll
            for (int i = 0; i < 4; ++i) { part[(w * 16 + 4 * (lane >> 4) + i) * 32 + (lane & 15)] = a0[i]; part[(w * 16 + 4 * (lane >> 4) + i) * 32 + 16 + (lane & 15)] = a1[i]; }
            __syncthreads();
            { const int tk = tid >> 5, e = tid & 31; float s = rb[e];
#pragma unroll
              for (int ww = 0; ww < 8; ++ww) s += part[(ww * 16 + tk) * 32 + e];
              logit[(16 * g + tk) * 33 + e] = s; }
        }
        __syncthreads();
        if (tid < chsz) {
            float v0 = -INFINITY, v1 = -INFINITY, v2 = -INFINITY, v3 = -INFINITY; int e0 = 0, e1 = 0, e2 = 0, e3 = 0;
            for (int e = 0; e < 32; ++e) { const float x = logit[tid * 33 + e];
                if (x > v0) { v3 = v2; e3 = e2; v2 = v1; e2 = e1; v1 = v0; e1 = e0; v0 = x; e0 = e; }
                else if (x > v1) { v3 = v2; e3 = e2; v2 = v1; e2 = e1; v1 = x; e1 = e; }
                else if (x > v2) { v3 = v2; e3 = e2; v2 = x; e2 = e; }
                else if (x > v3) { v3 = x; e3 = e; } }
            const float p1 = __expf(v1 - v0), p2 = __expf(v2 - v0), p3 = __expf(v3 - v0), inv = 1.0f / (1.0f + p1 + p2 + p3);
            const int tl = tid;
            rec_e[tl * 4 + 0] = e0; rec_e[tl * 4 + 1] = e1; rec_e[tl * 4 + 2] = e2; rec_e[tl * 4 + 3] = e3;
            rec_g[tl * 4 + 0] = inv; rec_g[tl * 4 + 1] = p1 * inv; rec_g[tl * 4 + 2] = p2 * inv; rec_g[tl * 4 + 3] = p3 * inv;
            rec_p[tl * 4 + 0] = atomicAdd(&hist[e0], 1); rec_p[tl * 4 + 1] = atomicAdd(&hist[e1], 1); rec_p[tl * 4 + 2] = atomicAdd(&hist[e2], 1); rec_p[tl * 4 + 3] = atomicAdd(&hist[e3], 1);
        }
        __syncthreads();
        if (tid < 32) base[tid] = (int)__hip_atomic_fetch_add(cnt + tid, (unsigned)hist[tid], __ATOMIC_RELAXED, __HIP_MEMORY_SCOPE_AGENT);
        __syncthreads();
        for (int idx = tid; idx < chsz * 4; idx += 512) { const int e = rec_e[idx], pos = base[e] + rec_p[idx]; tok_e[c0 * 4 + idx] = e; tok_pos[c0 * 4 + idx] = pos; tok_gate[c0 * 4 + idx] = rec_g[idx];
            tok_list[e * NTOK + pos] = c0 + (idx >> 2); }
        __syncthreads();
    }
}

DI void moe_tables(LAS int* tab, const unsigned* cnt) {
    const int tid = ld_tid();
    if (tid < 64) {
        const int e = tid & 31;
        const int n = tid < 32 ? ((int)__hip_atomic_load(cnt + e, __ATOMIC_RELAXED, __HIP_MEMORY_SCOPE_AGENT) + 255) >> 8 : 0;
        int incl = n;
#pragma unroll
        for (int o = 1; o < 32; o <<= 1) { const int v = __shfl_up(incl, o); if (tid >= o) incl += v; }
        const int excl = incl - n;
        if (tid < 32) { tab[32 + e] = excl * 256;
#pragma nounroll
            for (int j = 0; j < n; ++j) if (excl + j < MAXMT) tab[64 + excl + j] = e;
            if (tid == 31) tab[0] = incl < MAXMT ? incl : MAXMT; }
    }
    __syncthreads();
}
DI void phase_scatter(const LAS int* tab, const unsigned char* H8, unsigned char* XP, const int* tok_e, const int* tok_pos, int* tok_slot, int G, int ntok) {
    const int tid_ = ld_tid(); const int lane = tid_ & 63, gw = blockIdx.x * 8 + (tid_ >> 6);
    for (int tok = gw; tok < ntok; tok += G * 8) {
        int slot = 0;
        if (lane < 4) { slot = tab[32 + tok_e[tok * 4 + lane]] + tok_pos[tok * 4 + lane]; tok_slot[tok * 4 + lane] = slot; }
        const u32x4 a = *(const u32x4*)(H8 + (size_t)tok * 1024 + 16 * lane);
#pragma unroll
        for (int k = 0; k < 4; ++k) { const int s = __shfl(slot, k); *(u32x4*)(XP + (size_t)s * 1024 + 16 * lane) = a; }
    }
}
DI void phase_combine(const Params& P, int li, const bf16_t* X1, bf16_t* X2, const unsigned char* YB, const LAS int* tab, const int* tok_e, const int* tok_pos, const float* tok_gate, const float* modl, const float* modn, bf16_t* H, int G) {
    const int tid_ = ld_tid(); const int lane = tid_ & 63, gw = blockIdx.x * 8 + (tid_ >> 6);
    const bool last = (li == DEPTH - 1);
    const int N = last ? NLAT : NTOK, S = G * 8;
    int sl[2][4]; float gt[2][4];
    auto ldidx = [&](int tA, int (&s_)[2][4], float (&g_)[2][4]) __attribute__((always_inline)) {
#pragma unroll
        for (int q = 0; q < 2; ++q) { int t = tA + q * S; t = t < N ? t : gw;
            const v4i e4 = *(const v4i*)(tok_e + t * 4), p4 = *(const v4i*)(tok_pos + t * 4); const f32x4 g4 = *(const f32x4*)(tok_gate + t * 4);
#pragma unroll
            for (int k = 0; k < 4; ++k) { s_[q][k] = tab[32 + e4[k]] + p4[k]; g_[q][k] = g4[k]; } } };
    if (gw < N) ldidx(gw, sl, gt);
    for (int tok = gw; tok < N; tok += 2 * S) {
        u32x4 xa[2][2]; u32x2 ya[2][4][2];
#pragma unroll
        for (int q = 0; q < 2; ++q) { int t = tok + q * S; t = t < N ? t : tok;
            xa[q][0] = *(const u32x4*)(X1 + (size_t)t * 1024 + 8 * lane); xa[q][1] = *(const u32x4*)(X1 + (size_t)t * 1024 + 512 + 8 * lane);
#pragma unroll
            for (int k = 0; k < 4; ++k) { ya[q][k][0] = *(const u32x2*)(YB + (size_t)sl[q][k] * 1024 + 8 * lane); ya[q][k][1] = *(const u32x2*)(YB + (size_t)sl[q][k] * 1024 + 512 + 8 * lane); } }
        float gc[2][4];
#pragma unroll
        for (int q = 0; q < 2; ++q)
#pragma unroll
            for (int k = 0; k < 4; ++k) gc[q][k] = gt[q][k];
        { const int nt = tok + 2 * S; ldidx(nt < N ? nt : gw, sl, gt); }
#pragma unroll
        for (int q = 0; q < 2; ++q) { const int t = tok + q * S;
            if (t < N) {
                const int b9 = t < NLAT ? (t >> 12) : 8;
                f32x4 v[4];
                { const u32x4 a = xa[q][0], b = xa[q][1];
                  v[0] = (f32x4){bflo(a[0]), bfhi(a[0]), bflo(a[1]), bfhi(a[1])}; v[1] = (f32x4){bflo(a[2]), bfhi(a[2]), bflo(a[3]), bfhi(a[3])};
                  v[2] = (f32x4){bflo(b[0]), bfhi(b[0]), bflo(b[1]), bfhi(b[1])}; v[3] = (f32x4){bflo(b[2]), bfhi(b[2]), bflo(b[3]), bfhi(b[3])}; }
                f32x4 y[4];
#pragma unroll
                for (int j = 0; j < 4; ++j) y[j] = (f32x4){0.f, 0.f, 0.f, 0.f};
#pragma unroll
                for (int k = 0; k < 4; ++k) { const float g = gc[q][k]; const u32x2 a = ya[q][k][0], b = ya[q][k][1];
                    { const f32x2 p0 = __builtin_amdgcn_cvt_pk_f32_fp8((int)a.x, false), p1 = __builtin_amdgcn_cvt_pk_f32_fp8((int)a.x, true), p2 = __builtin_amdgcn_cvt_pk_f32_fp8((int)a.y, false), p3 = __builtin_amdgcn_cvt_pk_f32_fp8((int)a.y, true);
                      y[0] += g * (f32x4){p0.x, p0.y, p1.x, p1.y}; y[1] += g * (f32x4){p2.x, p2.y, p3.x, p3.y}; }
                    { const f32x2 p0 = __builtin_amdgcn_cvt_pk_f32_fp8((int)b.x, false), p1 = __builtin_amdgcn_cvt_pk_f32_fp8((int)b.x, true), p2 = __builtin_amdgcn_cvt_pk_f32_fp8((int)b.y, false), p3 = __builtin_amdgcn_cvt_pk_f32_fp8((int)b.y, true);
                      y[2] += g * (f32x4){p0.x, p0.y, p1.x, p1.y}; y[3] += g * (f32x4){p2.x, p2.y, p3.x, p3.y}; } }
                const float* g2 = modl + b9 * 6144 + 5 * 1024;
#pragma unroll
                for (int j = 0; j < 4; ++j) { const int k = (j >> 1) * 512 + 8 * lane + 4 * (j & 1); v[j] += *(const f32x4*)(g2 + k) * y[j]; }
                if (last) { float* o = P.out + (size_t)t * 1024; *(f32x4*)(o + 8 * lane) = v[0]; *(f32x4*)(o + 8 * lane + 4) = v[1]; *(f32x4*)(o + 512 + 8 * lane) = v[2]; *(f32x4*)(o + 512 + 8 * lane + 4) = v[3]; }
                else { store_row_bf16(X2 + (size_t)t * 1024, lane, v);
                    const float* md = modn + b9 * 6144;
                    modnorm_row(v, lane, P.norm1_g + (li + 1) * 1024, md, md + 1024);
                    store_row_bf16(H + (size_t)t * 1024, lane, v); }
            } }
    }
}

DI int invperm32(int c) { return 16 * ((c >> 2) & 1) + 4 * (c >> 3) + (c & 3); }
DI int fwd_win(int n) {
    if (n < 256) { const int hd = n >> 6, d = n & 63; return (d >> 5) * 128 + hd * 32 + (d & 31); }
    if (n < 384) { const int m = n - 256, hd = m >> 6, d = m & 63; return 256 + (d >> 5) * 128 + hd * 32 + (d & 31); }
    if (n < 512) { const int m = n - 384, kvh = m >> 6, d = m & 63; return 256 + 128 * (d >> 5) + 32 * (2 + kvh) + invperm32(d & 31); }
    if (n < 1024) { const int m = n - 512; return 512 + (m & ~31) + invperm32(m & 31); }
    if (n < 1280) return -1;
    if (n < 1792) { const int m = n - 1280, T = m >> 8, r = m & 255, hd = r >> 6, c = (r >> 5) & 1, dim = r & 31;
        const int nn = (dim >> 3) & 1, fq = 2 * (dim >> 4) + ((dim >> 2) & 1), i = dim & 3; return 1024 + T * 256 + c * 128 + hd * 32 + 16 * nn + 4 * fq + i; }
    return 4096 + (n - 1792);
}
DI int fwd_gu(int n) { const int bj = n >> 10, r = n & 1023, T = r >> 7, rr = r & 127; return T * 256 + bj * 128 + (rr & ~31) + invperm32(rr & 31); }
DI int fwd_lane16(int c) { const int pn = c >> 8, r = c & 255, wc = r >> 6, fq = (r >> 4) & 3, bj = (r >> 3) & 1, nn = (r >> 2) & 1, i = r & 3; return pn * 256 + bj * 128 + wc * 32 + nn * 16 + fq * 4 + i; }
DI int fwd_dn(int n) { return fwd_lane16(n); }
constexpr int PREP_T_IN = 32 * 8, PREP_T_OUT = 16 * 8, PREP_T_GU = NE * 32 * 8, PREP_T_DN = NE * 16 * 8, PREP_TILES_L = PREP_T_IN + PREP_T_OUT + PREP_T_GU + PREP_T_DN, PREP_TILES_S = PREP_T_IN + PREP_T_OUT;
DI void phase_prep(unsigned char* lds, const Params& P, int G) {
    const int tid = ld_tid(), blk = blockIdx.x;
    unsigned char* ws = P.ws;
    float* lc = (float*)lds; float* ls = lc + 4096;
    for (int j = tid; j < 4096; j += 512) { float s, c; sincospif((float)j * (1.0f / 2048.0f), &s, &c); lc[j] = c; ls[j] = s; }
    __syncthreads();
    {
      if (blk == 0) { bf16_t* M1 = (bf16_t*)(ws + WS_M1);
          for (int idx = tid; idx < 128 * 128; idx += 512) { const int row = idx >> 7, k = idx & 127, ri = row >> 6, k1 = row & 63, part = k >> 6, t1 = k & 63; const int j = ((k1 * t1) & 63) * 64;
              const float c = lc[j], sn = ls[j]; M1[idx] = (bf16_t)(pk2(ri == 0 ? (part == 0 ? c : -sn) : (part == 0 ? -sn : -c), 0.f) & 0xffffu); } }
      if (blk == 1 % G) { bf16_t* M3 = (bf16_t*)(ws + WS_M3);
          for (int idx = tid; idx < 64 * 128; idx += 512) { const int k2 = idx >> 7, k = idx & 127, part = k >> 6, t2 = k & 63; const int j = ((k2 * t2) & 63) * 64;
              M3[idx] = (bf16_t)(pk2((part == 0 ? lc[j] : ls[j]) * (1.0f / 64.0f), 0.f) & 0xffffu); } }
      if (blk == 2 % G) { float* TW = (float*)(ws + WS_TW);
          for (int idx = tid; idx < 64 * 64; idx += 512) { const int k1 = idx >> 6, t2 = idx & 63; const int j = (k1 * t2) & 4095; TW[2 * idx] = lc[j]; TW[2 * idx + 1] = ls[j]; } }
      bf16_t* TC = (bf16_t*)(ws + WS_TC);
      for (int k = blk; k < 256; k += G)
          for (int chunk = tid; chunk < 64; chunk += 512) { const int part = chunk >> 5, t0 = (chunk & 31) * 8; float v[8];
#pragma unroll
              for (int e = 0; e < 8; ++e) { const int j = ((k * (t0 + e)) & 255) * 16; v[e] = (part ? -ls[j] : lc[j]) * (1.0f / 16.0f); }
              store16(TC + (size_t)k * 512 + part * 256 + t0, (f32x4){v[0], v[1], v[2], v[3]}, (f32x4){v[4], v[5], v[6], v[7]}); } }
    { float* wv = (float*)(lds + 32768);
      for (int u = blk; u < DEPTH * 64; u += G) { const int li = u >> 6, k0 = (u & 63) * 16;
          for (int idx = tid; idx < 16 * 64; idx += 512) { const int row = idx >> 6, c4 = (idx & 63) * 4;
              *(f32x4*)(wv + row * 256 + c4) = *(const f32x4*)(P.w_in + ((size_t)li * 1024 + k0 + row) * 2048 + 1024 + c4); }
          __syncthreads();
          const int ch = tid & 255, part = tid >> 8, g = ch >> 6, cp = ch & 63;
          float acc[16];
#pragma unroll
          for (int kk = 0; kk < 16; ++kk) acc[kk] = 0.f;
          const float* tw = part ? ls : lc;
          for (int c = 0; c < 64; ++c) { const float t = tw[((c * cp) & 63) * 64];
#pragma unroll
              for (int kk = 0; kk < 16; ++kk) acc[kk] += wv[kk * 256 + 64 * g + c] * t; }
          bf16_t* d = (bf16_t*)(ws + WS_WCH + (size_t)li * SZ_WCH) + (size_t)(256 + 256 * part + ch) * 1024 + k0;
          store16(d, (f32x4){acc[0], acc[1], acc[2], acc[3]} * 0.125f, (f32x4){acc[4], acc[5], acc[6], acc[7]} * 0.125f);
          store16(d + 8, (f32x4){acc[8], acc[9], acc[10], acc[11]} * 0.125f, (f32x4){acc[12], acc[13], acc[14], acc[15]} * 0.125f);
          __syncthreads(); } }
    { unsigned* tl = (unsigned*)(lds + 32768);
      const int n4 = (tid & 15) * 4, kp = tid >> 4;
      auto decode = [&](int t, const float*& src, int& ld, int& type, int& n0, int& k0, int& li) __attribute__((always_inline)) {
          li = t / PREP_TILES_S; int u = t % PREP_TILES_S;
          if (u < PREP_T_IN) { src = P.w_in + (size_t)li * 1024 * 2048; ld = 2048; type = 0; }
          else { u -= PREP_T_IN; src = P.w_out + (size_t)li * 1024 * 1024; ld = 1024; type = 2; }
          const int nnt = ld >> 6; n0 = (u % nnt) * 64; k0 = (u / nnt) * 128; };
      f32x4 ra[4], rb[4], rc[4];
      auto issue = [&](int t, f32x4 (&r)[4]) __attribute__((always_inline)) { const float* src; int ld, type, n0, k0, li; decode(t, src, ld, type, n0, k0, li);
          const float* p = src + (size_t)(k0 + 2 * kp) * ld + n0 + n4;
          r[0] = *(const f32x4*)p; r[1] = *(const f32x4*)(p + ld); r[2] = *(const f32x4*)(p + (size_t)64 * ld); r[3] = *(const f32x4*)(p + (size_t)65 * ld); };
      int par = 0;
      auto proc = [&](int t, const f32x4 (&cur)[4]) __attribute__((always_inline)) {
          const float* src; int ld, type, n0, k0, li; decode(t, src, ld, type, n0, k0, li);
          unsigned* tlp = tl + par * (64 * 68); par ^= 1;
#pragma unroll
          for (int j = 0; j < 4; ++j) { tlp[(n4 + j) * 68 + kp] = pk2(cur[0][j], cur[1][j]); tlp[(n4 + j) * 68 + 32 + kp] = pk2(cur[2][j], cur[3][j]); }
          __syncthreads();
          const int nl = tid >> 3, c8 = tid & 7, n = n0 + nl;
          int p = type == 0 ? fwd_win(n) : fwd_lane16(n);
          size_t base = type == 0 ? WS_WTOK + (size_t)li * SZ_WTOK : WS_WOUT + (size_t)li * SZ_WOUT;
          if (p >= 4096) { p -= 4096; base = WS_WCH + (size_t)li * SZ_WCH; }
          bf16_t* d = (bf16_t*)(ws + base);
          if (p >= 0) { const u32x4 a = *(const u32x4*)(tlp + nl * 68 + 4 * c8), b = *(const u32x4*)(tlp + nl * 68 + 32 + 4 * c8);
              *(u32x4*)(d + (size_t)p * 1024 + k0 + 8 * c8) = a; *(u32x4*)(d + (size_t)p * 1024 + k0 + 64 + 8 * c8) = b; } };
      constexpr int NTILES = DEPTH * PREP_TILES_S;
      int t = blk;
      if (t < NTILES) issue(t, ra);
      if (t + G < NTILES) issue(t + G, rb);
      while (t < NTILES) {
          if (t + 2 * G < NTILES) issue(t + 2 * G, rc);
          proc(t, ra); t += G; if (t >= NTILES) break;
          if (t + 2 * G < NTILES) issue(t + 2 * G, ra);
          proc(t, rb); t += G; if (t >= NTILES) break;
          if (t + 2 * G < NTILES) issue(t + 2 * G, rb);
          proc(t, rc); t += G;
      }
      __syncthreads();
    }
    { float* sc = (float*)(lds + 32768); float* red = sc + 9216;
      for (int mb = blk; mb < DEPTH * 128; mb += G) { const int li = mb >> 7, cb = mb & 127;
          for (int idx = tid; idx < 9216; idx += 512) { const int r = idx >> 10, k = idx & 1023; const float v = r < 8 ? P.c[r * 1024 + k] : P.c_ctx[k]; sc[idx] = v * sigmoidf_(v); }
          __syncthreads();
          if (tid < 384) { const int cg = tid % 12, ks = tid / 12;
              f32x4 acc[9];
#pragma unroll
              for (int r = 0; r < 9; ++r) acc[r] = (f32x4){0.f, 0.f, 0.f, 0.f};
              for (int k0 = 32 * ks; k0 < 32 * ks + 32; k0 += 8) {
                  f32x4 w4[8];
#pragma unroll
                  for (int j = 0; j < 8; ++j) w4[j] = *(const f32x4*)(P.ada_w + ((size_t)li * 1024 + k0 + j) * 6144 + 48 * cb + 4 * cg);
#pragma unroll
                  for (int j = 0; j < 8; ++j)
#pragma unroll
                      for (int r = 0; r < 9; ++r) acc[r] += sc[r * 1024 + k0 + j] * w4[j]; }
#pragma unroll
              for (int r = 0; r < 9; ++r) *(f32x4*)(red + ks * 432 + (r * 12 + cg) * 4) = acc[r]; }
          __syncthreads();
          if (tid < 432) { const int r = tid / 48, cc = tid % 48; float s = P.ada_b[li * 6144 + 48 * cb + cc];
              for (int ks = 0; ks < 32; ++ks) s += red[ks * 432 + tid];
              ((float*)(ws + WS_MOD))[(size_t)(li * 9 + r) * 6144 + 48 * cb + cc] = s; }
          __syncthreads(); } }
    if (blk == G - 1) { float* rp = (float*)(ws + WS_ROPE);
        for (int idx = tid; idx < 1024; idx += 512) { const int pos = idx >> 4, f = idx & 15; const double ang = (double)pos * pow(10000.0, -(double)f / 16.0); rp[idx] = (float)cos(ang); rp[1024 + idx] = (float)sin(ang); }
        for (int idx = tid; idx < 512; idx += 512) { const int pos = idx >> 3, f = idx & 7; const double ang = (double)pos * pow(10000.0, -(double)f / 8.0); rp[2048 + idx] = (float)cos(ang); rp[2560 + idx] = (float)sin(ang); } }
}

constexpr int NPHASE = 2 + 8 * DEPTH;
#ifndef PHMASK
#define PHMASK 0xFFFFFFFFu
#endif
#ifndef SUBMASK
#define SUBMASK 0xFFu
#endif
#define SUBEN(j) ((SUBMASK >> (j)) & 1u)
#define PHEN(k) ((PHMASK >> ((k) < 2 ? (k) : 2 + (((k) - 2) & 7))) & 1u)

#define IN(k) (PHEN(k) && lo <= (k) && (k) < hi)
#define SEAM(k) do { if (IN(k) && IN((k) + 1)) { KParamsPtr kq = kparams(); XcdBarrier bar; bar.bar = (unsigned*)(kq->ws + WS_BAR); bar.x = xb_xcc_id(); bar.st = (volatile LAS unsigned*)(ldsL + LDS_BARW); xcd_barrier(bar); } } while (0)
#define WSP(T, off) ((T*)(ws + (off)))
#ifndef REPMASK
#define REPMASK 0u
#endif
#ifndef SUBREP
#define SUBREP 0u
#endif
#ifndef REP_N
#define REP_N 1
#endif
#define NREP(j) ((((REPMASK) >> (j)) & 1u) ? (1 + REP_N) : 1)
#define NSUB(x) ((((SUBREP) >> (x)) & 1u) ? (1 + REP_N) : 1)
#define FORCEBAR() do { KParamsPtr kq = kparams(); XcdBarrier bar; bar.bar = (unsigned*)(kq->ws + WS_BAR); bar.x = xb_xcc_id(); bar.st = (volatile LAS unsigned*)(ldsL + LDS_BARW); xcd_barrier(bar); } while (0)
#define REPBEG(j) for (int rep_ = 0; rep_ < NREP(j); ++rep_) {
#define REPEND(j) if (rep_ + 1 < NREP(j)) FORCEBAR(); }
#define CNTP(r) (WSP(unsigned, WS_CNT) + (li * 4 + (r)) * 64)


template <int li>
DI void layer_phases(unsigned char* smem, LAS unsigned char* ldsL, const int lo, const int hi) {
        const int pb = 2 + 8 * li;
        REPBEG(2) if (IN(pb)) {
            for (int srep_ = 0; srep_ < NSUB(0); ++srep_) if (SUBEN(0)) { KParamsPtr kp = kparams(); unsigned char* ws = kp->ws;
              SchedProjTok S{(unsigned)(WS_WTOK + (size_t)li * SZ_WTOK), (int)gridDim.x, vcu(), li == DEPTH - 1};
              { LAS float* rl = (LAS float*)(ldsL + LDS_ROPE); const float* rg = WSP(const float, WS_ROPE);
                for (int idx = ld_tid(); idx < 65 * 48; idx += 512) { int tb, o; if (idx < 2 * 65 * 16) { tb = idx / (65 * 16); o = idx % (65 * 16); } else { const int j = idx - 2 * 65 * 16; tb = 2 + j / (65 * 8); o = j % (65 * 8); }
                    const int w = tb < 2 ? 16 : 8, pos = o / w, f = o % w; const bool cosine = (tb & 1) == 0;
                    rl[idx] = pos < 64 ? rg[(tb < 2 ? tb * 1024 : 2048 + (tb - 2) * 512) + pos * w + f] : (cosine ? 1.0f : 0.0f); }
                __syncthreads(); }
              EpiProjTok E{li, (LAS const float*)(ldsL + LDS_ROPE)};
              pg8::gemm_phase<EpiProjTok, SchedProjTok, false>(ldsL, ws, 2048u, 2048u, 16, S, E); }
            for (int srep_ = 0; srep_ < NSUB(1); ++srep_) if (SUBEN(1)) { KParamsPtr kp = kparams(); unsigned char* ws = kp->ws;
              SchedProjCh S{(unsigned)(WS_WCH + (size_t)li * SZ_WCH), (int)gridDim.x, (int)((vcu() + gridDim.x - 48) % gridDim.x), li == DEPTH - 1};
              EpiProjCh E{};
              pg8::gemm_phase<EpiProjCh, SchedProjCh, true>(ldsL, ws, 2048u, 2048u, 16, S, E); }
        }
        REPEND(2)
        SEAM(pb);
        REPBEG(3) if (IN(pb + 1)) {
            { KParamsPtr kp = kparams(); unsigned char* ws = kp->ws;
              fft_load_a(smem + FF1_A, WSP(const bf16_t, WS_M1), 128);
              for (int L = blockIdx.x; L < 512; L += gridDim.x) fft1_unit(smem, ws, L);
              asm volatile("s_waitcnt vmcnt(0)" ::: "memory"); __syncthreads();
              if (threadIdx.x == 0) { __builtin_amdgcn_fence(__ATOMIC_RELEASE, "agent"); (void)xb_add(CNTP(3), 1u); } }
            for (int srep_ = 0; srep_ < NSUB(2); ++srep_) if (SUBEN(2)) { KParamsPtr kp = kparams(); unsigned char* ws = kp->ws; const int G = gridDim.x, lane = ld_tid() & 63;
              const float lam_init = 0.8f - 0.6f * __expf(-0.3f * (float)li);
              float lam;
              { const float* dl = kp->d_lambda + li * 128; float a = 0.f, b = 0.f; if (lane < 32) { a = dl[lane] * dl[32 + lane]; b = dl[64 + lane] * dl[96 + lane]; }
                lam = __expf(wave_sum(a)) - __expf(wave_sum(b)) + lam_init; }
              bf16_t* QD = WSP(bf16_t, WS_QD); bf16_t* KD = WSP(bf16_t, WS_KD); bf16_t* VTD = WSP(bf16_t, WS_VTD); bf16_t* CAT = WSP(bf16_t, WS_CAT);
              for (int L = blockIdx.x; L < (li == DEPTH - 1 ? 512 : 512 + 32); L += G) {
                AttnArgs a; int b, hd, qrow;
                if (L < 512) { b = L >> 6; hd = (L >> 4) & 3; qrow = b * SEQ + (L & 15) * 256; a.t0 = 0; } else { const int j = L - 512; b = j >> 2; hd = j & 3; qrow = NLAT + b * CTX; a.t0 = 64; }
                a.t1 = 68; a.q = QD + (size_t)qrow * 256 + hd * 64; a.klat = KD + (size_t)(b * SEQ) * 256 + hd * 64; a.kctx = KD + (size_t)(NLAT + b * CTX) * 256 + hd * 64; a.kpitch = 256;
                a.vt = VTD + (size_t)((b * 4 + hd) * 64) * KEYS; a.out = CAT + (size_t)qrow * 1024 + 768 + hd * 64; a.lam = lam; a.oscale = 1.0f - lam_init; a.subg = kp->d_subg + li * 64; a.wl = -1; a.wli = li;
                attn_unit<true>(smem, a);
              } }
            { KParamsPtr kq = kparams(); unsigned* bar = (unsigned*)(kq->ws + WS_BAR); unsigned* flag = (unsigned*)(kq->ws + WS_CNT) + (li * 4 + 3) * 64;
              if (threadIdx.x == 0) { const unsigned G_ = gridDim.x; XB_SPIN(xb_ld(flag) < G_, bar); __builtin_amdgcn_fence(__ATOMIC_ACQUIRE, "agent"); asm volatile("s_waitcnt vmcnt(0)" ::: "memory"); }
              __syncthreads(); }
            { KParamsPtr kp = kparams(); unsigned char* ws = kp->ws;
              fft_load_a(smem + FF3_A, WSP(const bf16_t, WS_M3), 64);
              for (int L = blockIdx.x; L < 512; L += gridDim.x) fft3_unit(smem, ws, L); }
            for (int srep_ = 0; srep_ < NSUB(3); ++srep_) if (SUBEN(3)) { KParamsPtr kp = kparams(); unsigned char* ws = kp->ws; const int G = gridDim.x;
              bf16_t* QA = WSP(bf16_t, WS_QA); bf16_t* KA = WSP(bf16_t, WS_KA); bf16_t* VTA = WSP(bf16_t, WS_VTA); bf16_t* CAT = WSP(bf16_t, WS_CAT);
              for (int it = 0; ; ++it) {
                int L = (int)blockIdx.x + it * G;
                if (G == 256 && it == 2) { const int j = (int)blockIdx.x - 32; if (j < 0 || j >= 32) break; L = 512 + j; }
                if (L >= (li == DEPTH - 1 ? 512 : 512 + 32)) break;
                AttnArgs a; int b, hd, qrow;
                if (L < 512) { b = L >> 6; hd = (L >> 4) & 3; qrow = b * SEQ + (L & 15) * 256; a.t0 = 0; } else { const int j = L - 512; b = j >> 2; hd = j & 3; qrow = NLAT + b * CTX; a.t0 = 64; }
                a.t1 = 68; a.q = QA + (size_t)qrow * 256 + hd * 64; a.klat = KA + (size_t)(b * SEQ) * 128 + (hd >> 1) * 64; a.kctx = KA + (size_t)(NLAT + b * CTX) * 128 + (hd >> 1) * 64; a.kpitch = 128;
                a.vt = VTA + (size_t)((b * 2 + (hd >> 1)) * 64) * KEYS; a.out = CAT + (size_t)qrow * 1024 + hd * 64; a.lam = 0.f; a.oscale = 1.f; a.subg = nullptr; a.wl = L < 512 ? L : -1; a.wli = li;
                attn_unit<false>(smem, a);
              } }
            for (int srep_ = 0; srep_ < NSUB(5); ++srep_) if (SUBEN(5) && li < DEPTH - 1) { KParamsPtr kp = kparams(); unsigned char* ws = kp->ws;
              SchedFourCtx S{(int)gridDim.x, (int)((blockIdx.x + gridDim.x - 96 % gridDim.x) % gridDim.x)}; EpiFourier E{};
              pg8::gemm_phase<EpiFourier, SchedFourCtx, true>(ldsL, ws, 1024u, 1024u, 8, S, E); }
            for (int srep_ = 0; srep_ < NSUB(6); ++srep_) if (SUBEN(6)) { KParamsPtr kp = kparams(); unsigned char* ws = kp->ws; const int G = gridDim.x;
              for (int it = 0; ; ++it) {
                int L = (int)blockIdx.x + it * G;
                if (G == 256 && it == 2) { const int j = (int)blockIdx.x - 64; if (j < 0 || j >= 32) break; L = 512 + j; }
                if (L >= (li == DEPTH - 1 ? 512 : 512 + 32)) break;
                int seqrow, Ls, t0;
                if (L < 512) { seqrow = (L >> 6) * SEQ; Ls = SEQ; t0 = (L & 63) * 64; } else { const int j = L - 512; seqrow = NLAT + (j >> 2) * CTX; Ls = CTX; t0 = (j & 3) * 64; }
                conv_unit(smem, seqrow, Ls, t0, WSP(const bf16_t, WS_BU), WSP(const bf16_t, WS_BG), kp->conv_w + li * 31 * 256, kp->conv_b + li * 256, kp->conv_lg + li * 256, kp->conv_lb + li * 256, WSP(bf16_t, WS_CAT));
              } }
        }
        REPEND(3)
        SEAM(pb + 1);
        REPBEG(4) if (IN(pb + 2)) { KParamsPtr kp = kparams(); unsigned char* ws = kp->ws;
            SchedOut S{(unsigned)(WS_WOUT + (size_t)li * SZ_WOUT), (int)gridDim.x, vcu(), li == DEPTH - 1 ? 128 : NTILE_TOK};
            EpiOut E{li};
            pg8::gemm_phase<EpiOut, SchedOut, false>(ldsL, ws, 2048u, 2048u, 16, S, E);
        }
        REPEND(4)
        SEAM(pb + 2);
        REPBEG(5) if (IN(pb + 3)) { const Params P = *kparams(); unsigned char* ws = P.ws;
            phase_router(smem, P, li, WSP(const bf16_t, WS_X1), WSP(unsigned char, WS_H8), WSP(const float, WS_MOD) + (size_t)li * 9 * 6144, CNTP(rep_), WSP(int, WS_TOKE), WSP(int, WS_TOKP), WSP(float, WS_TOKG), WSP(int, WS_TOKL), gridDim.x, li == DEPTH - 1 ? NLAT : NTOK, li == DEPTH - 1 ? 128 : RT_CH); }
        REPEND(5)
        SEAM(pb + 3);
        REPBEG(7) if (IN(pb + 5)) { KParamsPtr kp = kparams(); unsigned char* ws = kp->ws; LAS int* tab = (LAS int*)(ldsL + LDS_TAB);
            moe_tables(tab, CNTP(NREP(5) - 1));
            SchedMoe<8, true> S{0u, (unsigned)(WS_WGU + (size_t)li * SZ_WGU), 2048u * 1024u, tab, (int)gridDim.x, (int)blockIdx.x};
            EpiMoe1 E{li};
            pg8::gemm_phase<EpiMoe1, SchedMoe<8, true>, false, true, true>(ldsL, ws, 1024u, 1024u, 8, S, E); }
        REPEND(7)
        SEAM(pb + 5);
        REPBEG(8) if (IN(pb + 6)) { KParamsPtr kp = kparams(); unsigned char* ws = kp->ws; LAS int* tab = (LAS int*)(ldsL + LDS_TAB);
            if (!IN(pb + 5)) moe_tables(tab, CNTP(NREP(5) - 1));
            SchedMoe<4> S{(unsigned)WS_ACT, (unsigned)(WS_WDN + (size_t)li * SZ_WDN), 1024u * 1024u, tab, (int)gridDim.x, (int)blockIdx.x};
            EpiMoe2 E{li};
            pg8::gemm_phase<EpiMoe2, SchedMoe<4>, false, true>(ldsL, ws, 1024u, 1024u, 8, S, E); }
        REPEND(8)
        SEAM(pb + 6);
        REPBEG(9) if (IN(pb + 7)) { const Params P = *kparams(); unsigned char* ws = P.ws; const float* MOD = WSP(const float, WS_MOD); LAS int* tab = (LAS int*)(ldsL + LDS_TAB);
            if (!IN(pb + 5)) moe_tables(tab, CNTP(NREP(5) - 1));
            phase_combine(P, li, WSP(const bf16_t, WS_X1), WSP(bf16_t, WS_X2), WSP(const unsigned char, WS_XP) + (size_t)MAXMT * 256 * 1024, tab, WSP(const int, WS_TOKE), WSP(const int, WS_TOKP), WSP(const float, WS_TOKG), MOD + (size_t)li * 9 * 6144, MOD + (size_t)(li + 1 < DEPTH ? li + 1 : li) * 9 * 6144, WSP(bf16_t, WS_H), gridDim.x); }
        REPEND(9)
        SEAM(pb + 7);
}

__global__ void __launch_bounds__(512, 2) mega(Params Pdummy) {
    extern __shared__ __attribute__((aligned(16))) unsigned char smem[];
    LAS unsigned char* ldsL = (LAS unsigned char*)smem;
    if (threadIdx.x < 4) ((LAS unsigned*)(ldsL + LDS_BARW))[threadIdx.x] = 0u;
    __syncthreads();
    { KParamsPtr kp = kparams(); (void)xcd_barrier_post((unsigned*)(kp->ws + WS_BAR), (volatile LAS unsigned*)(ldsL + LDS_BARW)); }
    int lo, hi; { KParamsPtr kp = kparams(); lo = kp->ph_lo; hi = kp->ph_hi; }
    REPBEG(0) if (IN(0)) { const Params P = *kparams(); phase_prep(smem, P, gridDim.x); } REPEND(0)
    SEAM(0);
    REPBEG(1) if (IN(1)) { const Params P = *kparams(); unsigned char* ws = P.ws; phase_norm1(P, WSP(bf16_t, WS_H), WSP(const float, WS_MOD), gridDim.x); } REPEND(1)
    SEAM(1);
    layer_phases<0>(smem, ldsL, lo, hi);
    layer_phases<1>(smem, ldsL, lo, hi);
    static_assert(DEPTH == 2, "two layers are written out");
#undef IN
#undef SEAM
}

#ifndef MK_MULTI
#define MK_MULTI 0
#endif
extern "C" void kernel_launch(void* const* d_in, const int* in_sizes, int n_in, void* d_out, int out_size, void* d_ws, size_t ws_size, hipStream_t stream) {
    static int grid = 0;
    if (grid == 0) {
        if (n_in != 26 || ws_size < WS_END) { fprintf(stderr, "kernel_launch: need 26 inputs and %zu bytes of workspace (got %d, %zu)\n", (size_t)WS_END, n_in, ws_size); grid = -1; return; }
        int dev = 0, cus = 0, per_cu = 0;
        if (hipGetDevice(&dev) != hipSuccess || hipDeviceGetAttribute(&cus, hipDeviceAttributeMultiprocessorCount, dev) != hipSuccess) { grid = -1; return; }
        if (hipFuncSetAttribute((const void*)mega, hipFuncAttributeMaxDynamicSharedMemorySize, LDS_BYTES) != hipSuccess) { fprintf(stderr, "kernel_launch: hipFuncSetAttribute failed\n"); grid = -1; return; }
        if (hipOccupancyMaxActiveBlocksPerMultiprocessor(&per_cu, (const void*)mega, 512, LDS_BYTES) != hipSuccess || per_cu < 1) fprintf(stderr, "kernel_launch: occupancy query says %d\n", per_cu);
        (void)hipGetLastError();
        grid = cus;
    }
    if (grid < 0) return;
    (void)hipMemsetAsync(d_ws, 0, WS_ZERO_BYTES, stream);
    Params p{};
    const float** pf = (const float**)&p;
    for (int i = 0; i < 26; ++i) pf[i] = (const float*)d_in[i];
    p.out = (float*)d_out; p.ws = (unsigned char*)d_ws;
#if MK_MULTI
    for (int k = 0; k < NPHASE; ++k) { p.ph_lo = k; p.ph_hi = k + 1; hipLaunchKernelGGL(mega, dim3(grid), dim3(512), LDS_BYTES, stream, p); }
#else
    p.ph_lo = 0; p.ph_hi = NPHASE;
    hipLaunchKernelGGL(mega, dim3(grid), dim3(512), LDS_BYTES, stream, p);
#ifdef EXTRA_PHASE
    p.ph_lo = EXTRA_PHASE; p.ph_hi = EXTRA_PHASE + 1;
    hipLaunchKernelGGL(mega, dim3(grid), dim3(512), LDS_BYTES, stream, p);
#endif
#endif
}
```

```cpp
#include <hip/hip_runtime.h>
#include <stdint.h>
#include <stdio.h>

#define DI __device__ __forceinline__
#define LAS __attribute__((address_space(3)))
typedef unsigned short bf16_t;
typedef short bf16x8 __attribute__((ext_vector_type(8)));
typedef short s16x4 __attribute__((ext_vector_type(4)));
typedef float f32x2 __attribute__((ext_vector_type(2)));
typedef float f32x4 __attribute__((ext_vector_type(4)));
typedef float f32x16 __attribute__((ext_vector_type(16)));
typedef unsigned u32x2 __attribute__((ext_vector_type(2)));
typedef unsigned u32x4 __attribute__((ext_vector_type(4)));
typedef __bf16 bf16x2_t __attribute__((ext_vector_type(2)));
typedef int v4i __attribute__((ext_vector_type(4)));
typedef int v8i __attribute__((ext_vector_type(8)));

constexpr int DM = 1024, NB = 8, SEQ = 4096, CTX = 256, NLAT = NB * SEQ, NCTX = NB * CTX, NTOK = NLAT + NCTX, DEPTH = 2;
constexpr int NE = 32, TOPK = 4, KEYS = SEQ + CTX;
constexpr int NTILE_TOK = NTOK / 256;
constexpr int MAXMT = 576;
constexpr float EPS = 1e-6f;
constexpr float LOG2E = 1.4426950408889634f;
constexpr float W8_SCALE = 64.0f, W8_INV = 1.0f / 64.0f;

constexpr size_t al256(size_t x) { return (x + 255) & ~(size_t)255; }
constexpr size_t WS_BAR = 0;
constexpr size_t WS_CNT = 16384;
constexpr size_t WS_ZERO_BYTES = 20480;
constexpr size_t WS_MOD = WS_ZERO_BYTES;
constexpr size_t WS_ROPE = al256(WS_MOD + (size_t)DEPTH * 9 * 6144 * 4);
constexpr size_t WS_TOKE = al256(WS_ROPE + 3072 * 4);
constexpr size_t WS_TOKP = al256(WS_TOKE + (size_t)NTOK * 4 * 4);
constexpr size_t WS_TOKG = al256(WS_TOKP + (size_t)NTOK * 4 * 4);
constexpr size_t WS_TOKS = al256(WS_TOKG + (size_t)NTOK * 4 * 4);
constexpr size_t WS_WTOK = al256(WS_TOKS + (size_t)NTOK * 4 * 4);
constexpr size_t SZ_WTOK = (size_t)1536 * 1024 * 2;
constexpr size_t WS_WCH = WS_WTOK + DEPTH * SZ_WTOK;
constexpr size_t SZ_WCH = (size_t)1024 * 1024 * 2;
constexpr size_t WS_WOUT = WS_WCH + DEPTH * SZ_WCH;
constexpr size_t SZ_WOUT = (size_t)1024 * 1024 * 2;
constexpr size_t WS_WGU = WS_WOUT + DEPTH * SZ_WOUT;
constexpr size_t SZ_WGU = (size_t)NE * 2048 * 1024 * 2;
constexpr size_t WS_WDN = WS_WGU + DEPTH * SZ_WGU;
constexpr size_t SZ_WDN = (size_t)NE * 1024 * 1024 * 2;
constexpr size_t WS_TL = WS_WDN + DEPTH * SZ_WDN;
constexpr size_t WS_Y2 = WS_TL;
constexpr size_t WS_M1 = WS_TL + (size_t)NB * 64 * 256 * 128 * 2;
constexpr size_t WS_M3 = WS_M1 + 128 * 128 * 2;
constexpr size_t WS_TW = WS_M3 + 64 * 128 * 2;
constexpr size_t WS_TC = WS_TL + (size_t)4096 * 8192 * 2;
constexpr size_t WS_H = WS_TC + (size_t)256 * 512 * 2;
constexpr size_t WS_QA = WS_H + (size_t)NTOK * 1024 * 2;
constexpr size_t WS_KA = WS_QA + (size_t)NTOK * 256 * 2;
constexpr size_t WS_BU = WS_KA + (size_t)NTOK * 128 * 2;
constexpr size_t WS_BG = WS_BU + (size_t)NTOK * 256 * 2;
constexpr size_t WS_QD = WS_BG + (size_t)NTOK * 256 * 2;
constexpr size_t WS_KD = WS_QD + (size_t)NTOK * 256 * 2;
constexpr size_t WS_VTA = WS_KD + (size_t)NTOK * 256 * 2;
constexpr size_t WS_VTD = WS_VTA + (size_t)NB * 2 * 64 * KEYS * 2;
constexpr size_t WS_FT = WS_VTD + (size_t)NB * 4 * 64 * KEYS * 2;
constexpr size_t WS_FTC = WS_FT + (size_t)NB * 256 * 8192 * 2;
constexpr size_t WS_CAT = WS_FTC + (size_t)NB * 256 * 512 * 2;
constexpr size_t WS_X1 = WS_CAT + (size_t)NTOK * 1024 * 2;
constexpr size_t WS_X2 = WS_X1 + (size_t)NTOK * 1024 * 2;
constexpr size_t WS_XP = WS_X2 + (size_t)NTOK * 1024 * 2;
constexpr size_t WS_ACT = WS_XP + (size_t)MAXMT * 256 * 1024 * 2;
constexpr size_t WS_H8 = WS_ACT + (size_t)MAXMT * 256 * 1024 * 2;
constexpr size_t WS_TOKL = WS_H8 + (size_t)NTOK * 1024;
constexpr size_t WS_END = WS_TOKL + ((size_t)NE * NTOK + 1024) * 4;

constexpr int LDS_GEMM = 131072;
constexpr int LDS_TAB = LDS_GEMM;
constexpr int LDS_TOKT = LDS_TAB + 3072;
constexpr int LDS_BARW = LDS_GEMM + 4096;
constexpr int LDS_ROPE = LDS_BARW + 16;
constexpr int LDS_BYTES = LDS_ROPE + 65 * 48 * 4;

struct Params {
    const float* x; const float* c; const float* ctx; const float* c_ctx;
    const float* norm1_g; const float* norm2_g; const float* ada_w; const float* ada_b; const float* w_in;
    const float* a_qg; const float* a_kg; const float* conv_w; const float* conv_b; const float* conv_lg; const float* conv_lb;
    const float* d_qg; const float* d_kg; const float* d_lambda; const float* d_subg; const float* w_out;
    const float* router_w; const float* router_b; const float* w_gu; const float* b_gu; const float* w_dn; const float* b_dn;
    float* out; unsigned char* ws;
    int ph_lo, ph_hi;
};

#if defined(__HIP_DEVICE_COMPILE__)
typedef const Params __attribute__((address_space(4))) * KParamsPtr;
#else
typedef const Params* KParamsPtr;
#endif
DI KParamsPtr kparams() { KParamsPtr p = (KParamsPtr)__builtin_amdgcn_kernarg_segment_ptr(); asm volatile("" : "+s"(p)); return p; }
DI int ld_tid() { int t = threadIdx.x; asm volatile("" : "+v"(t)); return t; }
DI int vcu() { const int G = gridDim.x, c = blockIdx.x; return (G & 7) == 0 ? (c & 7) * (G >> 3) + (c >> 3) : c; }

DI unsigned pk2(float lo, float hi) { f32x2 v = {lo, hi}; bf16x2_t b = __builtin_convertvector(v, bf16x2_t); return __builtin_bit_cast(unsigned, b); }
DI unsigned pk4_fp8(float a, float b, float c, float d) { int r = 0; r = __builtin_amdgcn_cvt_pk_fp8_f32(a, b, r, false); r = __builtin_amdgcn_cvt_pk_fp8_f32(c, d, r, true); return (unsigned)r; }
DI float clamp448(float x) { return __builtin_amdgcn_fmed3f(x, -448.0f, 448.0f); }
DI float bf2f(bf16_t b) { return __uint_as_float(((unsigned)b) << 16); }
DI float bflo(unsigned u) { return __uint_as_float(u << 16); }
DI float bfhi(unsigned u) { return __uint_as_float(u & 0xffff0000u); }
DI float wave_sum(float v) {
#pragma unroll
    for (int o = 32; o >= 1; o >>= 1) v += __shfl_xor(v, o);
    return v;
}
DI float sum_x16_x32(float v) {
    { const auto r = __builtin_amdgcn_permlane16_swap(__float_as_uint(v), __float_as_uint(v), false, false); v = __uint_as_float(r[0]) + __uint_as_float(r[1]); }
    { const auto r = __builtin_amdgcn_permlane32_swap(__float_as_uint(v), __float_as_uint(v), false, false); v = __uint_as_float(r[0]) + __uint_as_float(r[1]); }
    return v;
}
DI float sigmoidf_(float x) { return 1.0f / (1.0f + __expf(-x)); }
DI int perm32(int rho) { const int n = rho >> 4, i = rho & 15; return 8 * (i >> 2) + 4 * n + (i & 3); }

#define XB_TMO      128
#define XB_XCNT(j)  (256  + 64 * (j))
#define XB_XSUB(j)  (1280 + 64 * (j))
#define XB_XGEN(j)  (2304 + 64 * (j))
#define XB_TOP      3328
#define XB_TOPGEN   3392
#define XCD_BAR_WORDS 3456
#define XB_SPIN_CAP (1u << 18)
DI unsigned xb_ld(unsigned* p)              { return __hip_atomic_load(p, __ATOMIC_RELAXED, __HIP_MEMORY_SCOPE_AGENT); }
DI unsigned xb_add(unsigned* p, unsigned v) { return __hip_atomic_fetch_add(p, v, __ATOMIC_RELAXED, __HIP_MEMORY_SCOPE_AGENT); }
DI unsigned xb_xcc_id() { return (unsigned)__builtin_amdgcn_s_getreg((3 << 11) | 20) & 0xFu; }
#define XB_SPIN(cond, bar) do { unsigned _sp = 0; while (cond) { __builtin_amdgcn_s_sleep(1); \
    if ((++_sp & 255u) == 0u) { if (xb_ld(&(bar)[XB_TMO])) break; if (_sp > XB_SPIN_CAP) { atomicAdd(&(bar)[XB_TMO], 1u); break; } } } } while (0)
struct XcdBarrier { unsigned* bar; unsigned x; volatile LAS unsigned* st; };
DI XcdBarrier xcd_barrier_post(unsigned* bar, volatile LAS unsigned* st) {
    XcdBarrier b; b.bar = bar; b.x = xb_xcc_id(); b.st = st;
    if (threadIdx.x == 0) (void)xb_add(&bar[XB_XCNT(b.x)], 1u);
    return b;
}
DI void xcd_barrier_complete(unsigned* bar, unsigned x, unsigned& nloc, unsigned& nx) {
    const unsigned G = gridDim.x * gridDim.y * gridDim.z;
    unsigned sum, cnt, mine, sp = 0u;
    for (;;) {
        sum = 0u; cnt = 0u; mine = 0u;
#pragma unroll
        for (unsigned j = 0; j < 16; ++j) { const unsigned c = xb_ld(&bar[XB_XCNT(j)]); sum += c; cnt += (c > 0u) ? 1u : 0u; mine = (j == x) ? c : mine; }
        if (sum == G) break;
        __builtin_amdgcn_s_sleep(1);
        if ((++sp & 255u) == 0u) { if (xb_ld(&bar[XB_TMO])) break; if (sp > XB_SPIN_CAP) { atomicAdd(&bar[XB_TMO], 1u); break; } }
    }
    nloc = mine > 0u ? mine : 1u; nx = cnt > 0u ? cnt : 1u;
}
DI void xcd_barrier(const XcdBarrier& b) {
    asm volatile("s_waitcnt vmcnt(0)" ::: "memory");
    __syncthreads();
    if (threadIdx.x == 0) {
        unsigned* bar = b.bar;
        __builtin_amdgcn_s_waitcnt(0);
        unsigned nloc = b.st[0], nx = b.st[1];
        if (nloc == 0u) { xcd_barrier_complete(bar, b.x, nloc, nx); b.st[0] = nloc; b.st[1] = nx; }
        const unsigned old = xb_add(&bar[XB_XSUB(b.x)], 1u);
        const unsigned gen = old / nloc;
        if (old + 1u == (gen + 1u) * nloc) {
            __builtin_amdgcn_fence(__ATOMIC_RELEASE, "agent");
            asm volatile("s_waitcnt vmcnt(0)" ::: "memory");
            const unsigned og = xb_add(&bar[XB_TOP], 1u);
            const unsigned tg = og / nx;
            if (og + 1u == (tg + 1u) * nx) xb_add(&bar[XB_TOPGEN], 1u);
            else XB_SPIN(xb_ld(&bar[XB_TOPGEN]) == tg, bar);
            __builtin_amdgcn_fence(__ATOMIC_ACQUIRE, "agent");
            xb_add(&bar[XB_XGEN(b.x)], 1u);
            asm volatile("s_waitcnt vmcnt(0)" ::: "memory");
        } else {
            XB_SPIN(xb_ld(&bar[XB_XGEN(b.x)]) == gen, bar);
            __builtin_amdgcn_fence(__ATOMIC_ACQUIRE, "agent");
            asm volatile("s_waitcnt vmcnt(0)" ::: "memory");
        }
    }
    __syncthreads();
}

namespace pg8 {
constexpr int BK = 64, HALF = 128, HTB = HALF * BK * 2, STAGE_BYTES = 8 * HTB;
DI int lds_byte(int r, int c) { const int st = (r >> 4) * 2 + (c >> 5), rr = r & 15, cc = c & 31, ob = rr * 64 + cc * 2; return st * 1024 + (ob ^ (((ob >> 9) & 1) << 5)); }
DI void stage_rc(int b, int& R, int& C) { const int st = b / 1024, sb = b % 1024, swz = sb ^ (((sb >> 9) & 1) << 5); R = (st >> 1) * 16 + swz / 64; C = (st & 1) * 32 + (swz % 64) / 2; }
struct GUnit { unsigned A, B; int pm, pn, e; };

template <class Epi, class Sched, bool PERM, bool FP8 = false, bool GATHER = false>
DI void gemm_phase(LAS unsigned char* lds, const unsigned char* wsb, const unsigned lda, const unsigned ldb, const int nt, const Sched& S, const Epi& E) {
    int tid = threadIdx.x; asm volatile("" : "+v"(tid));
    const int wid = __builtin_amdgcn_readfirstlane(tid >> 6), lane = tid & 63, wr = wid >> 2, wc = wid & 3, fr = lane & 15, fq = lane >> 4;
    unsigned voffA[2], voffB[2];
#pragma unroll
    for (int i = 0; i < 2; ++i) { int R, C; stage_rc(tid * 16 + i * 8192, R, C); const int Rb = PERM ? ((R & ~31) + perm32(R & 31)) : R;
        voffA[i] = (unsigned)R * lda + (unsigned)C * 2u; voffB[i] = (unsigned)Rb * ldb + (unsigned)C * 2u; }
    const unsigned kstep = (unsigned)(BK * 2);
    const unsigned hstepA = (unsigned)HALF * lda, hstepB = (unsigned)HALF * ldb;
    unsigned offC[2][2];
#pragma unroll
    for (int i = 0; i < 2; ++i) offC[0][i] = offC[1][i] = 0u;
    const int* tokl = (const int*)(wsb + WS_TOKL);
    LAS int* tokt = (LAS int*)(lds + LDS_TOKT);
    const unsigned ldsw = (unsigned)wid * 1024u;
    const LAS unsigned char* pa = lds + lds_byte(wr * 64 + fr, fq * 8); const LAS unsigned char* pb = lds + 4 * HTB + lds_byte(wc * 32 + fr, fq * 8);
    asm volatile("" : "+v"(pa), "+v"(pb));
#define PG8_SA(b, h) (((b) * 2 + (h)) * HTB)
#define PG8_SB(b, h) ((4 + (b) * 2 + (h)) * HTB)
#define PG8_STAGE(bufoff, gbase, voff) do { _Pragma("unroll") for (int _i = 0; _i < 2; ++_i) \
        __builtin_amdgcn_global_load_lds((const unsigned*)(wsb + (size_t)(gbase) + (voff)[_i]), (LAS unsigned*)(lds + (bufoff) + ldsw + _i * 8192), 16, 0, 0); } while (0)
#define PG8_STAGEA(bufoff, kt, h, nx) do { if constexpr (GATHER) { _Pragma("unroll") for (int _i = 0; _i < 2; ++_i) \
        __builtin_amdgcn_global_load_lds((const unsigned*)(wsb + WS_H8 + (size_t)((unsigned)(kt) * kstep) + offC[h][_i]), (LAS unsigned*)(lds + (bufoff) + ldsw + _i * 8192), 16, 0, 0); } \
        else PG8_STAGE(bufoff, ((nx) ? nA : cA) + (unsigned)(kt) * kstep + (unsigned)(h) * hstepA, voffA); } while (0)
#define PG8_LD8(p, off) __builtin_shufflevector(*(const LAS v4i*)((p) + (off)), *(const LAS v4i*)((p) + (off) + 1024), 0, 1, 2, 3, 4, 5, 6, 7)
#define PG8_LDA(dst, b, h) do { _Pragma("unroll") for (int m = 0; m < 4; ++m) { if constexpr (FP8) dst##8[m] = PG8_LD8(pa, PG8_SA(b, h) + m * 2048); \
        else { _Pragma("unroll") for (int k = 0; k < 2; ++k) dst[m][k] = *(const LAS bf16x8*)(pa + PG8_SA(b, h) + m * 2048 + k * 1024); } } } while (0)
#define PG8_LDB(dst, b, h) do { _Pragma("unroll") for (int n = 0; n < 2; ++n) { if constexpr (FP8) dst##8[n] = PG8_LD8(pb, PG8_SA(b, h) + n * 2048); \
        else { _Pragma("unroll") for (int k = 0; k < 2; ++k) dst[n][k] = *(const LAS bf16x8*)(pb + PG8_SA(b, h) + n * 2048 + k * 1024); } } } while (0)
#define PG8_CAT(x) __builtin_shufflevector(__builtin_bit_cast(v4i, (x)[0]), __builtin_bit_cast(v4i, (x)[1]), 0, 1, 2, 3, 4, 5, 6, 7)
#define PG8_MMA(ai, bj, At, Bt) do { __builtin_amdgcn_s_setprio(1); _Pragma("unroll") for (int m = 0; m < 4; ++m) _Pragma("unroll") for (int n = 0; n < 2; ++n) { \
        if constexpr (FP8) acc[ai][bj][m][n] = __builtin_amdgcn_mfma_scale_f32_16x16x128_f8f6f4(Bt##8[n], At##8[m], acc[ai][bj][m][n], 0, 0, 0, 0, 0, 0); \
        else { _Pragma("unroll") for (int k = 0; k < 2; ++k) acc[ai][bj][m][n] = __builtin_amdgcn_mfma_f32_16x16x32_bf16(Bt[n][k], At[m][k], acc[ai][bj][m][n], 0, 0, 0); } } \
        __builtin_amdgcn_s_setprio(0); } while (0)
#define PG8_WAIT_V(n) asm volatile("s_waitcnt vmcnt(" #n ")" ::: "memory")
#define PG8_WAIT_L(n) asm volatile("s_waitcnt lgkmcnt(" #n ")" ::: "memory")
#define PG8_BAR __builtin_amdgcn_s_barrier()
#define PG8_SCHED __builtin_amdgcn_sched_barrier(0)
    GUnit cur, nxt; int ui = 0;
    if (!S.next(0, cur)) return;
    f32x4 acc[2][2][4][2];
#pragma unroll
    for (int a = 0; a < 2; ++a)
#pragma unroll
        for (int b = 0; b < 2; ++b)
#pragma unroll
            for (int m = 0; m < 4; ++m)
#pragma unroll
                for (int n = 0; n < 2; ++n) acc[a][b][m][n] = (f32x4){0.f, 0.f, 0.f, 0.f};
    bf16x8 At[4][2], B0[2][2], B1[2][2]; v8i At8[4], B08[2], B18[2];
    unsigned cA = cur.A, cB = cur.B, nA = cur.A, nB = cur.B;
    if constexpr (GATHER) {
#pragma unroll
        for (int i = 0; i < 2; ++i) { int R, C; stage_rc(tid * 16 + i * 8192, R, C);
#pragma unroll
            for (int h = 0; h < 2; ++h) { const unsigned tk = (unsigned)tokl[cur.A + h * HALF + R]; offC[h][i] = (tk < (unsigned)NTOK ? tk : (unsigned)(NTOK - 1)) * lda + (unsigned)C * 2u; } }
        asm volatile("" : "+v"(offC[0][0]), "+v"(offC[0][1]), "+v"(offC[1][0]), "+v"(offC[1][1]));
    }
    PG8_STAGE(PG8_SB(0, 0), cB, voffB); PG8_STAGE(PG8_SB(0, 1), cB + hstepB, voffB); PG8_STAGEA(PG8_SA(0, 0), 0, 0, false); PG8_STAGEA(PG8_SA(0, 1), 0, 1, false);
    if (wr == 1) PG8_BAR;
    PG8_WAIT_V(2); PG8_BAR;
    PG8_STAGE(PG8_SB(1, 0), cB + kstep, voffB); PG8_STAGEA(PG8_SA(1, 0), 1, 0, false); PG8_STAGE(PG8_SB(1, 1), cB + hstepB + kstep, voffB);
    PG8_WAIT_V(6); PG8_BAR;
    for (;;) {
        const bool has_next = S.next(ui + 1, nxt);
        nA = has_next ? nxt.A : cA; nB = has_next ? nxt.B : cB;
        if constexpr (GATHER) {
            if (wid < 4) __builtin_amdgcn_global_load_lds((const unsigned*)(tokl + nA + tid), (LAS unsigned*)(tokt + wid * 64), 4, 0, 0);
        }
#pragma nounroll
        for (int t = 0; t < nt; t += 2) {
            const bool last = (t == nt - 2);
            const unsigned b2 = last ? nB : cB + (unsigned)(t + 2) * kstep, b3 = b2 + kstep;
            const int k2 = last ? 0 : t + 2, k3 = k2 + 1;
            PG8_LDB(B0, 0, 0); PG8_LDB(B1, 0, 1); PG8_SCHED; PG8_LDA(At, 0, 0); PG8_STAGEA(PG8_SA(1, 1), t + 1, 1, false);
            if constexpr (GATHER) { if (last) {
                int tz = tid; asm volatile("" : "+v"(tz));
#pragma unroll
                for (int i = 0; i < 2; ++i) { int R, C; stage_rc(tz * 16 + i * 8192, R, C);
#pragma unroll
                    for (int h = 0; h < 2; ++h) { const unsigned tk = (unsigned)tokt[h * HALF + R]; offC[h][i] = (tk < (unsigned)NTOK ? tk : (unsigned)(NTOK - 1)) * lda + (unsigned)C * 2u; } } } }
            PG8_WAIT_V(8); PG8_WAIT_L(0); PG8_BAR; PG8_MMA(0, 0, At, B0); PG8_MMA(0, 1, At, B1); PG8_BAR; PG8_SCHED;
            PG8_LDA(At, 0, 1); PG8_STAGE(PG8_SB(0, 0), b2, voffB); PG8_STAGE(PG8_SB(0, 1), b2 + hstepB, voffB); PG8_STAGEA(PG8_SA(0, 0), k2, 0, last);
            PG8_WAIT_V(8); PG8_WAIT_L(0); PG8_BAR; PG8_MMA(1, 0, At, B0); PG8_MMA(1, 1, At, B1); PG8_BAR; PG8_SCHED;
            PG8_LDB(B0, 1, 0); PG8_LDB(B1, 1, 1); PG8_SCHED; PG8_LDA(At, 1, 0); PG8_STAGEA(PG8_SA(0, 1), k2, 1, last);
            PG8_WAIT_V(8); PG8_WAIT_L(0); PG8_BAR; PG8_MMA(0, 0, At, B0); PG8_MMA(0, 1, At, B1); PG8_BAR; PG8_SCHED;
            PG8_LDA(At, 1, 1); PG8_STAGE(PG8_SB(1, 0), b3, voffB); PG8_STAGE(PG8_SB(1, 1), b3 + hstepB, voffB); PG8_STAGEA(PG8_SA(1, 0), k3, 0, last);
            PG8_WAIT_V(8); PG8_WAIT_L(0); PG8_BAR; PG8_MMA(1, 0, At, B0); PG8_MMA(1, 1, At, B1); PG8_BAR; PG8_SCHED;
        }

        if (wr == 0) PG8_BAR;
        E(acc, cur, wsb, wr, wc, fr, fq);
        if (!has_next) break;
#pragma unroll
        for (int a = 0; a < 2; ++a)
#pragma unroll
            for (int b = 0; b < 2; ++b)
#pragma unroll
                for (int m = 0; m < 4; ++m)
#pragma unroll
                    for (int n = 0; n < 2; ++n) acc[a][b][m][n] = (f32x4){0.f, 0.f, 0.f, 0.f};
        cur = nxt; cA = nA; cB = nB; ++ui;
        if (wr == 1) PG8_BAR;
    }
    PG8_WAIT_V(0);
    PG8_BAR;
#undef PG8_SA
#undef PG8_SB
#undef PG8_STAGE
#undef PG8_STAGEA
#undef PG8_LDA
#undef PG8_LD8
#undef PG8_LDB
#undef PG8_MMA
#undef PG8_CAT
#undef PG8_WAIT_V
#undef PG8_WAIT_L
#undef PG8_BAR
#undef PG8_SCHED
}
}
using pg8::GUnit;
typedef f32x4 AccT[2][2][4][2];

constexpr float C2A = LOG2E * 0.125f;
constexpr float C2D = LOG2E * 0.17677669529663687f;

DI void store8(bf16_t* p, f32x4 a) { u32x2 w; w.x = pk2(a[0], a[1]); w.y = pk2(a[2], a[3]); *(u32x2*)p = w; }
DI void store16(bf16_t* p, f32x4 a, f32x4 b) { u32x4 w; w.x = pk2(a[0], a[1]); w.y = pk2(a[2], a[3]); w.z = pk2(b[0], b[1]); w.w = pk2(b[2], b[3]); *(u32x4*)p = w; }
#define EPI_ARGS const AccT& acc, const GUnit& u, const unsigned char* wsb, int wr, int wc, int fr, int fq
#define EPI_OPAQUE() asm volatile("" : "+v"(fr), "+v"(fq))
#define WSB(T, off) ((T*)(const_cast<unsigned char*>(wsb) + (off)))

struct EpiProjTok {
    int li; LAS const float* rope;
    DI void head64(const AccT& acc, int rbase, int wc, int fq, bf16_t* dst, int pitch, const float* gain, float scale) const {
        LAS const float* cs16 = rope; LAS const float* sn16 = rope + 65 * 16;
        f32x4 g[2][2];
#pragma unroll
        for (int bj = 0; bj < 2; ++bj)
#pragma unroll
            for (int n = 0; n < 2; ++n) g[bj][n] = *(const f32x4*)(gain + 32 * bj + 16 * n + 4 * fq);
#pragma unroll
        for (int ai = 0; ai < 2; ++ai)
#pragma unroll
            for (int m = 0; m < 4; ++m) {
                const int row = rbase + 128 * ai + 16 * m;
                float ss = 0.f;
#pragma unroll
                for (int bj = 0; bj < 2; ++bj)
#pragma unroll
                    for (int n = 0; n < 2; ++n)
#pragma unroll
                        for (int i = 0; i < 4; ++i) ss += acc[ai][bj][m][n][i] * acc[ai][bj][m][n][i];
                ss = sum_x16_x32(ss);
                const float rinv = __builtin_amdgcn_rsqf(ss * (1.0f / 64.0f) + EPS) * scale;
                const bool lat = row < NLAT; const int t = row & (SEQ - 1);
#pragma unroll
                for (int bj = 0; bj < 2; ++bj) {
                    const f32x4 x1 = acc[ai][bj][m][0] * rinv * g[bj][0], x2 = acc[ai][bj][m][1] * rinv * g[bj][1];
                    const int pos = lat ? (bj ? (t & 63) : (t >> 6)) : 64;
                    const f32x4 c = *(LAS const f32x4*)(cs16 + pos * 16 + 4 * fq), sn = *(LAS const f32x4*)(sn16 + pos * 16 + 4 * fq);
                    bf16_t* p = dst + (size_t)row * pitch + wc * 64 + 32 * bj + 4 * fq;
                    store8(p, x1 * c - x2 * sn); store8(p + 16, x1 * sn + x2 * c);
                }
            }
    }
    DI void head32x2(const AccT& acc, int rbase, int wc, int fq, bf16_t* dst, const float* gain, float scale) const {
        LAS const float* cs8 = rope + 2 * 65 * 16; LAS const float* sn8 = cs8 + 65 * 8;
        const int dbase = 16 * (fq >> 1) + 4 * (fq & 1);
        const f32x4 g0 = *(const f32x4*)(gain + dbase), g1 = *(const f32x4*)(gain + dbase + 8);
#pragma unroll
        for (int ai = 0; ai < 2; ++ai)
#pragma unroll
            for (int m = 0; m < 4; ++m) {
                const int row = rbase + 128 * ai + 16 * m;
                const bool lat = row < NLAT; const int t = row & (SEQ - 1);
                const int pos = lat ? ((fq >> 1) ? (t & 63) : (t >> 6)) : 64;
                const f32x4 c = *(LAS const f32x4*)(cs8 + pos * 8 + 4 * (fq & 1)), sn = *(LAS const f32x4*)(sn8 + pos * 8 + 4 * (fq & 1));
#pragma unroll
                for (int bj = 0; bj < 2; ++bj) {
                    float ss = 0.f;
#pragma unroll
                    for (int n = 0; n < 2; ++n)
#pragma unroll
                        for (int i = 0; i < 4; ++i) ss += acc[ai][bj][m][n][i] * acc[ai][bj][m][n][i];
                    ss = sum_x16_x32(ss);
                    const float rinv = __builtin_amdgcn_rsqf(ss * (1.0f / 32.0f) + EPS) * scale;
                    const f32x4 x1 = acc[ai][bj][m][0] * rinv * g0, x2 = acc[ai][bj][m][1] * rinv * g1;
                    bf16_t* p = dst + (size_t)row * 256 + wc * 64 + 32 * bj + dbase;
                    store8(p, x1 * c - x2 * sn); store8(p + 8, x1 * sn + x2 * c);
                }
            }
    }
    DI void plain(const AccT& acc, int rbase, int wc, int fq, bf16_t* dst) const {
#pragma unroll
        for (int ai = 0; ai < 2; ++ai)
#pragma unroll
            for (int m = 0; m < 4; ++m) {
                const int row = rbase + 128 * ai + 16 * m;
#pragma unroll
                for (int bj = 0; bj < 2; ++bj) store16(dst + (size_t)row * 256 + 128 * bj + 32 * wc + 8 * fq, acc[ai][bj][m][0], acc[ai][bj][m][1]);
            }
    }
    DI void vtrans(const AccT& acc, int rbase, int kvh, int fq, bf16_t* VTA) const {
#pragma unroll
        for (int ai = 0; ai < 2; ++ai)
#pragma unroll
            for (int m = 0; m < 4; ++m) {
                const int row = rbase + 128 * ai + 16 * m; const bool lat = row < NLAT;
                const int b = lat ? (row >> 12) : ((row - NLAT) >> 8), key = lat ? (row & (SEQ - 1)) : SEQ + ((row - NLAT) & (CTX - 1));
                bf16_t* p = VTA + ((size_t)(b * 2 + kvh) * 64 + 8 * fq) * KEYS + key;
#pragma unroll
                for (int bj = 0; bj < 2; ++bj)
#pragma unroll
                    for (int n = 0; n < 2; ++n)
#pragma unroll
                        for (int i = 0; i < 4; ++i) p[(size_t)(32 * bj + 4 * n + i) * KEYS] = (bf16_t)(pk2(acc[ai][bj][m][n][i], 0.f) & 0xffffu);
            }
    }
    DI void operator()(EPI_ARGS) const {
        EPI_OPAQUE();
        const int rbase = u.pm * 256 + wr * 64 + fr;
        if (u.pn == 0) head64(acc, rbase, wc, fq, WSB(bf16_t, WS_QA), 256, kparams()->a_qg + li * 64, C2A);
        else if (u.pn == 1) { if (wc < 2) head64(acc, rbase, wc, fq, WSB(bf16_t, WS_KA), 128, kparams()->a_kg + li * 64, 1.0f); else vtrans(acc, rbase, wc - 2, fq, WSB(bf16_t, WS_VTA)); }
        else if (u.pn == 2) plain(acc, rbase, wc, fq, WSB(bf16_t, WS_BU));
        else if (u.pn == 3) plain(acc, rbase, wc, fq, WSB(bf16_t, WS_BG));
        else if (u.pn == 4) head32x2(acc, rbase, wc, fq, WSB(bf16_t, WS_QD), kparams()->d_qg + li * 32, C2D);
        else head32x2(acc, rbase, wc, fq, WSB(bf16_t, WS_KD), kparams()->d_kg + li * 32, 1.0f);
    }
};
struct SchedProjTok {
    unsigned woff; int G, c; bool last;
    DI bool next(int i, GUnit& u) const { const int L = i * G + c; if (L >= (last ? 128 * 6 + 16 : NTILE_TOK * 6)) return false;
        if (L < 128 * 6 || !last) { u.pm = L / 6; u.pn = L % 6; } else { const int j = L - 128 * 6; u.pm = 128 + (j >> 1); u.pn = (j & 1) ? 5 : 1; }
        u.e = 0; u.A = (unsigned)WS_H + (unsigned)u.pm * (256u * 2048u); u.B = woff + (unsigned)u.pn * (256u * 2048u); return true; }
};

struct EpiProjCh {
    DI void operator()(EPI_ARGS) const {
        EPI_OPAQUE();
        const bool ctx = u.pn >= 128; const int b = ctx ? (u.pn - 128) : (u.pn >> 4); const int t0 = ctx ? 0 : (u.pn & 15) * 256;
        bf16_t* base; size_t pitch; int tokoff;
        if (u.pm == 0) { base = WSB(bf16_t, WS_VTD) + (size_t)b * 4 * 64 * KEYS; pitch = KEYS; tokoff = ctx ? SEQ : t0; }
        else if (!ctx) { base = WSB(bf16_t, WS_FT) + (size_t)b * 256 * 8192; pitch = 8192; tokoff = t0 + (u.pm == 2 ? 4096 : 0); }
        else { base = WSB(bf16_t, WS_FTC) + (size_t)b * 256 * 512; pitch = 512; tokoff = (u.pm == 2 ? 256 : 0); }
#pragma unroll
        for (int ai = 0; ai < 2; ++ai) {
#pragma unroll
            for (int m = 0; m < 4; ++m) {
                const int lrow = 128 * ai + 64 * wr + 16 * m + fr;
#pragma unroll
                for (int bj = 0; bj < 2; ++bj) store16(base + (size_t)lrow * pitch + tokoff + 128 * bj + 32 * wc + 8 * fq, acc[ai][bj][m][0], acc[ai][bj][m][1]);
            }
        }
    }
};
struct SchedProjCh {
    unsigned woff; int G, c; bool last;
    DI bool next(int i, GUnit& u) const { const int L = i * G + c; if (L >= (last ? 128 * 3 + 8 : NTILE_TOK * 3)) return false;
        if (L < 128 * 3 || !last) { u.pn = L / 3; u.pm = L % 3; } else { const int j = L - 128 * 3; u.pn = 128 + j; u.pm = 0; }
        u.e = 0; u.A = woff + (unsigned)u.pm * (256u * 2048u); u.B = (unsigned)WS_H + (unsigned)u.pn * (256u * 2048u); return true; }
};

struct EpiFourier {
    DI void operator()(EPI_ARGS) const {
        EPI_OPAQUE();
        bf16_t* CAT = WSB(bf16_t, WS_CAT);
        const int rbase = u.e + wr * 64 + fr;
#pragma unroll
        for (int ai = 0; ai < 2; ++ai)
#pragma unroll
            for (int m = 0; m < 4; ++m) {
                const int row = rbase + 128 * ai + 16 * m;
#pragma unroll
                for (int bj = 0; bj < 2; ++bj) store16(CAT + (size_t)row * 1024 + 512 + 128 * bj + 32 * wc + 8 * fq, acc[ai][bj][m][0], acc[ai][bj][m][1]);
            }
    }
};
struct SchedFourLat {
    int G, c;
    DI bool next(int i, GUnit& u) const { const int L = i * G + c; if (L >= 128) return false;
        const int b = L >> 4, mt = L & 15; u.pm = mt; u.pn = 0; u.e = b * SEQ + mt * 256; u.A = (unsigned)WS_TL + (unsigned)mt * (256u * 16384u); u.B = (unsigned)WS_FT + (unsigned)b * (256u * 16384u); return true; }
};
struct SchedFourCtx {
    int G, c;
    DI bool next(int i, GUnit& u) const { const int L = i * G + c; if (L >= 8) return false;
        u.pm = 0; u.pn = 0; u.e = NLAT + L * CTX; u.A = (unsigned)WS_TC; u.B = (unsigned)WS_FTC + (unsigned)L * (256u * 1024u); return true; }
};

struct EpiOut {
    int li;
    DI void operator()(EPI_ARGS) const {
        EPI_OPAQUE();
        const float* mod = WSB(const float, WS_MOD) + (size_t)li * 9 * 6144; bf16_t* X1 = WSB(bf16_t, WS_X1);
        const int rbase = u.pm * 256 + wr * 64 + fr, cbase = u.pn * 256 + 64 * wc + 16 * fq;
        const int b9 = (u.pm < 128) ? (u.pm >> 4) : 8;
        f32x4 g[2][2];
#pragma unroll
        for (int bj = 0; bj < 2; ++bj)
#pragma unroll
            for (int n = 0; n < 2; ++n) g[bj][n] = *(const f32x4*)(mod + b9 * 6144 + 2048 + cbase + 8 * bj + 4 * n);
        if (li == 0) {
            KParamsPtr kp = kparams(); const float* xb = (u.pm < 128) ? kp->x : kp->ctx - (size_t)NLAT * 1024;
#pragma unroll
            for (int ai = 0; ai < 2; ++ai) {
                f32x4 xv[4][2][2];
#pragma unroll
                for (int m = 0; m < 4; ++m)
#pragma unroll
                    for (int bj = 0; bj < 2; ++bj)
#pragma unroll
                        for (int n = 0; n < 2; ++n) xv[m][bj][n] = *(const f32x4*)(xb + (size_t)(rbase + 128 * ai + 16 * m) * 1024 + cbase + 8 * bj + 4 * n);
#pragma unroll
                for (int m = 0; m < 4; ++m)
#pragma unroll
                    for (int bj = 0; bj < 2; ++bj) store16(X1 + (size_t)(rbase + 128 * ai + 16 * m) * 1024 + cbase + 8 * bj, xv[m][bj][0] + g[bj][0] * acc[ai][bj][m][0], xv[m][bj][1] + g[bj][1] * acc[ai][bj][m][1]);
            }
        } else {
            const bf16_t* X2 = WSB(const bf16_t, WS_X2);
            u32x4 xv[2][4][2];
#pragma unroll
            for (int ai = 0; ai < 2; ++ai)
#pragma unroll
                for (int m = 0; m < 4; ++m)
#pragma unroll
                    for (int bj = 0; bj < 2; ++bj) xv[ai][m][bj] = *(const u32x4*)(X2 + (size_t)(rbase + 128 * ai + 16 * m) * 1024 + cbase + 8 * bj);
#pragma unroll
            for (int ai = 0; ai < 2; ++ai)
#pragma unroll
                for (int m = 0; m < 4; ++m)
#pragma unroll
                    for (int bj = 0; bj < 2; ++bj) { const u32x4 xi = xv[ai][m][bj];
                        store16(X1 + (size_t)(rbase + 128 * ai + 16 * m) * 1024 + cbase + 8 * bj,
                                (f32x4){bflo(xi.x), bfhi(xi.x), bflo(xi.y), bfhi(xi.y)} + g[bj][0] * acc[ai][bj][m][0], (f32x4){bflo(xi.z), bfhi(xi.z), bflo(xi.w), bfhi(xi.w)} + g[bj][1] * acc[ai][bj][m][1]); }
        }
    }
};
struct SchedOut {
    unsigned woff; int G, c, npanel;
    DI bool next(int i, GUnit& u) const { const int L = i * G + c; if (L >= npanel * 4) return false;
        u.pm = L / 4; u.pn = L % 4; u.e = 0; u.A = (unsigned)WS_CAT + (unsigned)u.pm * (256u * 2048u); u.B = woff + (unsigned)u.pn * (256u * 2048u); return true; }
};

struct EpiMoe1 {
    int li;
    DI void operator()(EPI_ARGS) const {
        EPI_OPAQUE();
        unsigned char* ACT = WSB(unsigned char, WS_ACT);
        const int rbase = u.pm * 256 + wr * 64 + fr, cbase = u.pn * 128 + 32 * wc + 8 * fq;
        const float* bb = kparams()->b_gu + ((size_t)li * NE + u.e) * 2048 + cbase;
        f32x4 bg[2], bu1[2];
#pragma unroll
        for (int n = 0; n < 2; ++n) { bg[n] = *(const f32x4*)(bb + 4 * n); bu1[n] = *(const f32x4*)(bb + 1024 + 4 * n) + 1.0f; }
#pragma unroll
        for (int ai = 0; ai < 2; ++ai)
#pragma unroll
            for (int m = 0; m < 4; ++m) {
                const int row = rbase + 128 * ai + 16 * m;
                f32x4 o[2];
#pragma unroll
                for (int n = 0; n < 2; ++n) {
                    const f32x4 gg = acc[ai][0][m][n] * W8_INV + bg[n], uu = acc[ai][1][m][n] * W8_INV + bu1[n];
                    f32x4 gv, u1, e;
#pragma unroll
                    for (int i = 0; i < 4; ++i) { gv[i] = fminf(gg[i], 7.0f); u1[i] = __builtin_amdgcn_fmed3f(uu[i], -6.0f, 8.0f); }
                    const f32x4 t = gv * (-1.702f * LOG2E);
#pragma unroll
                    for (int i = 0; i < 4; ++i) e[i] = __builtin_amdgcn_exp2f(t[i]);
                    const f32x4 d = e + 1.0f;
                    f32x4 r;
#pragma unroll
                    for (int i = 0; i < 4; ++i) r[i] = __builtin_amdgcn_rcpf(d[i]);
                    o[n] = gv * u1 * r;
                }
                u32x2 w; w.x = pk4_fp8(o[0][0], o[0][1], o[0][2], o[0][3]); w.y = pk4_fp8(o[1][0], o[1][1], o[1][2], o[1][3]);
                *(u32x2*)(ACT + (size_t)row * 1024 + cbase) = w;
            }
    }
};
struct EpiMoe2 {
    int li;
    DI void operator()(EPI_ARGS) const {
        EPI_OPAQUE();
        unsigned char* YB = WSB(unsigned char, WS_XP) + (size_t)MAXMT * 256 * 1024;
        const int rbase = u.pm * 256 + wr * 64 + fr, cbase = u.pn * 256 + 64 * wc + 16 * fq;
        const float* bb = kparams()->b_dn + ((size_t)li * NE + u.e) * 1024 + cbase;
        f32x4 bv[2][2];
#pragma unroll
        for (int bj = 0; bj < 2; ++bj)
#pragma unroll
            for (int n = 0; n < 2; ++n) bv[bj][n] = *(const f32x4*)(bb + 8 * bj + 4 * n);
#pragma unroll
        for (int ai = 0; ai < 2; ++ai)
#pragma unroll
            for (int m = 0; m < 4; ++m) {
                const int row = rbase + 128 * ai + 16 * m;
                u32x4 w;
#pragma unroll
                for (int bj = 0; bj < 2; ++bj)
#pragma unroll
                    for (int n = 0; n < 2; ++n) { const f32x4 a = acc[ai][bj][m][n] * W8_INV + bv[bj][n]; w[2 * bj + n] = pk4_fp8(clamp448(a[0]), clamp448(a[1]), clamp448(a[2]), clamp448(a[3])); }
                *(u32x4*)(YB + (size_t)row * 1024 + cbase) = w;
            }
    }
};
template <int nN, bool GATH = false> struct SchedMoe {
    unsigned aoff, woff, wstride_e; const LAS int* tab; int G, c;
    DI bool next(int i, GUnit& u) const { const int NT = __builtin_amdgcn_readfirstlane(tab[0]);
        if ((G & 7) == 0) { const int idx = i * (G >> 3) + (c >> 3), per = (NT + 7) >> 3, loc = idx / nN; u.pm = (c & 7) * per + loc; u.pn = idx % nN; if (loc >= per || u.pm >= NT) return false; }
        else { const int L = i * G + c; if (L >= NT * nN) return false; u.pm = L / nN; u.pn = L % nN; }
        u.e = __builtin_amdgcn_readfirstlane(tab[64 + u.pm]);
        u.A = GATH ? (unsigned)(u.e * NTOK + (u.pm * 256 - __builtin_amdgcn_readfirstlane(tab[32 + u.e]))) : aoff + (unsigned)u.pm * (256u * 1024u);
        u.B = woff + (unsigned)u.e * wstride_e + (unsigned)u.pn * (256u * 1024u); return true; }
};

DI int invperm32(int c);
DI int fwd_gu(int n);
DI int fwd_lane16(int c);
DI int fwd_dn(int n);
constexpr int AT_ROWB = 144;
constexpr int AT_VROWB = 136;
constexpr int AT_TILEB = 64 * AT_ROWB;
constexpr int AT_BUFB = AT_TILEB + 64 * AT_VROWB + 128;
struct AttnArgs {
    const bf16_t* q;
    const bf16_t* klat;
    const bf16_t* kctx;
    int kpitch;
    const bf16_t* vt;
    int t0, t1;
    bf16_t* out;
    float lam, oscale; const float* subg;
    int wl, wli;
};
constexpr int AT_NWT = 24;
constexpr int AT_WT = 55296;
DI f32x16 mfma32(bf16x8 a, bf16x8 b, f32x16 c) { return __builtin_amdgcn_mfma_f32_32x32x16_bf16(a, b, c, 0, 0, 0); }
DI bf16x8 packp(const f32x16& x, int s) { u32x4 p; p.x = pk2(x[8 * s], x[8 * s + 1]); p.y = pk2(x[8 * s + 2], x[8 * s + 3]); p.z = pk2(x[8 * s + 4], x[8 * s + 5]); p.w = pk2(x[8 * s + 6], x[8 * s + 7]); return __builtin_bit_cast(bf16x8, p); }

template <bool DIFF>
DI void attn_unit(unsigned char* lds, const AttnArgs& a) {
    int tid = threadIdx.x; asm volatile("" : "+v"(tid));
    const int lane = tid & 63, r = lane & 31, h = lane >> 5; const int wid = __builtin_amdgcn_readfirstlane(tid >> 6);
    bf16x8 qf[4];
    { const bf16_t* qp = a.q + (size_t)(wid * 32 + r) * 256 + 8 * h;
#pragma unroll
      for (int x = 0; x < 4; ++x) qf[x] = *(const bf16x8*)(qp + 16 * x); }
    const int lrow = tid >> 3, lch = tid & 7;
    const bf16_t* vsrc = a.vt + (size_t)lrow * KEYS + 8 * lch;
    const int ldst = lrow * AT_ROWB + lch * 16, ldstv = AT_TILEB + lrow * AT_VROWB + lch * 16;
    const int koff = r * AT_ROWB + 16 * h;
    const int voff = AT_TILEB + r * AT_VROWB + 8 * h;
    f32x16 o0[2], o1[2];
#pragma unroll
    for (int d = 0; d < 2; ++d) { o0[d] = (f32x16){}; o1[d] = (f32x16){}; }
    f32x4 l0 = {0.f, 0.f, 0.f, 0.f}, l1 = {0.f, 0.f, 0.f, 0.f};
    u32x4 kregA, vregA, kregB, vregB;
    auto gload = [&](int t, u32x4& kreg, u32x4& vreg) __attribute__((always_inline)) {
        const bf16_t* kp = (t < 64) ? a.klat + (size_t)(t * 64 + lrow) * a.kpitch : a.kctx + (size_t)((t - 64) * 64 + lrow) * a.kpitch;
        kreg = *(const u32x4*)(kp + 8 * lch);
        vreg = *(const u32x4*)(vsrc + (size_t)t * 64);
    };
    auto lstore = [&](int slot, const u32x4& kreg, const u32x4& vreg) __attribute__((always_inline)) { unsigned char* b = lds + slot * AT_BUFB; *(u32x4*)(b + ldst) = kreg; *(u32x2*)(b + ldstv) = (u32x2){vreg.x, vreg.y}; *(u32x2*)(b + ldstv + 8) = (u32x2){vreg.z, vreg.w}; };
    auto kread = [&](const unsigned char* Kb, int hh, bf16x8 (&kf)[4]) __attribute__((always_inline)) {
#pragma unroll
        for (int x = 0; x < 4; ++x) kf[x] = *(const bf16x8*)(Kb + koff + hh * 32 * AT_ROWB + 32 * x); };
    auto vread = [&](const unsigned char* Vb, int hh, bf16x8 (&vf)[2][2]) __attribute__((always_inline)) {
#pragma unroll
        for (int s2 = 0; s2 < 2; ++s2)
#pragma unroll
            for (int d = 0; d < 2; ++d) { const unsigned char* vp = Vb + voff + d * 32 * AT_VROWB + 64 * hh + 32 * s2;
                const s16x4 lo = *(const s16x4*)vp, hi = *(const s16x4*)(vp + 16); vf[s2][d] = __builtin_shufflevector(lo, hi, 0, 1, 2, 3, 4, 5, 6, 7); } };
    auto qk = [&](const bf16x8 (&kf)[4], f32x16& sa, f32x16& sb) __attribute__((always_inline)) {
        if (!DIFF) { sa = mfma32(kf[0], qf[0], (f32x16){}); sa = mfma32(kf[1], qf[1], sa); sa = mfma32(kf[2], qf[2], sa); sa = mfma32(kf[3], qf[3], sa); }
        else { sa = mfma32(kf[0], qf[0], (f32x16){}); sb = mfma32(kf[2], qf[2], (f32x16){}); sa = mfma32(kf[1], qf[1], sa); sb = mfma32(kf[3], qf[3], sb); }
    };
    auto expsum = [&](f32x16& sc, f32x4& l) __attribute__((always_inline)) {
#pragma unroll
        for (int i = 0; i < 16; ++i) sc[i] = __builtin_amdgcn_exp2f(sc[i]);
#pragma unroll
        for (int i = 0; i < 4; ++i) l += (f32x4){sc[4 * i], sc[4 * i + 1], sc[4 * i + 2], sc[4 * i + 3]};
    };
    auto pv1 = [&](const bf16x8 (&vf)[2][2], const f32x16& pa, f32x16 (&o)[2]) __attribute__((always_inline)) {
#pragma unroll
        for (int s2 = 0; s2 < 2; ++s2) { const bf16x8 pp = packp(pa, s2); o[0] = mfma32(vf[s2][0], pp, o[0]); o[1] = mfma32(vf[s2][1], pp, o[1]); }
    };
    f32x4 wq[4];
    const int wn4 = (tid & 63) * 4;
    constexpr int WPITCH = 36;
    auto w_decode = [&](int j, const float*& src, unsigned char*& dst, int& ld, int& n0, int& k0, bool& gu) __attribute__((always_inline)) {
        const int g = (j >> 2) * 512 + a.wl, e = g / 96, r = g - e * 96; KParamsPtr kp = kparams();
        if (r < 64) { src = kp->w_gu + ((size_t)a.wli * NE + e) * (1024 * 2048); dst = kp->ws + WS_WGU + (size_t)a.wli * SZ_WGU + (size_t)e * 2048 * 1024; ld = 2048; n0 = (r & 7) * 256; k0 = ((r >> 3) * 4 + (j & 3)) * 32; gu = true; }
        else { const int q = r - 64; src = kp->w_dn + ((size_t)a.wli * NE + e) * (1024 * 1024); dst = kp->ws + WS_WDN + (size_t)a.wli * SZ_WDN + (size_t)e * 1024 * 1024; ld = 1024; n0 = (q & 3) * 256; k0 = ((q >> 2) * 4 + (j & 3)) * 32; gu = false; } };
    auto w_issue = [&](int j) __attribute__((always_inline)) { const float* src; unsigned char* dst; int ld, n0, k0; bool gu; w_decode(j, src, dst, ld, n0, k0, gu);
        const float* p = src + (size_t)(k0 + 4 * wid) * ld + n0 + wn4;
        wq[0] = __builtin_nontemporal_load((const f32x4*)p); wq[1] = __builtin_nontemporal_load((const f32x4*)(p + ld));
        wq[2] = __builtin_nontemporal_load((const f32x4*)(p + (size_t)2 * ld)); wq[3] = __builtin_nontemporal_load((const f32x4*)(p + (size_t)3 * ld)); };
    auto w_cvt = [&]() __attribute__((always_inline)) { unsigned char* t8 = lds + AT_WT + wn4 * WPITCH + 4 * wid;
#pragma unroll
        for (int j = 0; j < 4; ++j) *(unsigned*)(t8 + j * WPITCH) = pk4_fp8(wq[0][j] * W8_SCALE, wq[1][j] * W8_SCALE, wq[2][j] * W8_SCALE, wq[3][j] * W8_SCALE); };
    auto w_store = [&](int j) __attribute__((always_inline)) { const float* src; unsigned char* dst; int ld, n0, k0; bool gu; w_decode(j, src, dst, ld, n0, k0, gu);
        const int col = tid >> 1, half = tid & 1, n = n0 + col; const int p = gu ? fwd_gu(n) : fwd_dn(n);
        const unsigned* t = (const unsigned*)(lds + AT_WT + col * WPITCH + 16 * half);
        *(u32x4*)(dst + (size_t)p * 1024 + k0 + 16 * half) = (u32x4){t[0], t[1], t[2], t[3]}; };
    const bool wrider = !DIFF && a.wl >= 0;
    if (wrider) w_issue(0);
    gload(a.t0, kregA, vregA); gload(a.t0 + 1 < a.t1 ? a.t0 + 1 : a.t0, kregB, vregB);
    lstore(0, kregA, vregA); lstore(1, kregB, vregB);
    __syncthreads();
    asm volatile("" : "+v"(qf[0]), "+v"(qf[1]), "+v"(qf[2]), "+v"(qf[3]));
    if (!DIFF && a.t0 + 2 < a.t1) gload(a.t0 + 2, kregA, vregA);
    f32x16 s0a, s0b, s1a, s1b; s0b = (f32x16){}; s1b = (f32x16){};
    bf16x8 kf[4], vf[2][2];
    kread(lds, 0, kf); qk(kf, s0a, s0b);
    int slot = 0;
    auto step = [&](int t, u32x4& kl, u32x4& vl, const u32x4& ks, const u32x4& vs, const int hk, const int wj) __attribute__((always_inline)) {
        const int slot1 = slot == 2 ? 0 : slot + 1, slot2 = slot1 == 2 ? 0 : slot1 + 1;
        if (!DIFF && hk == 1) { w_cvt(); w_issue(wj + 1 < AT_NWT ? wj + 1 : AT_NWT - 1); }
        if (!DIFF && hk == 2) w_store(wj);
        { const int tn = t + (DIFF ? 2 : 3); gload(tn < a.t1 ? tn : a.t1 - 1, kl, vl); }
        const unsigned char* Kb = lds + slot * AT_BUFB;
        if (!DIFF) {
            kread(Kb, 1, kf); vread(Kb, 0, vf);
            qk(kf, s1a, s1b);
            expsum(s0a, l0);
            pv1(vf, s0a, o0);
            kread(lds + slot1 * AT_BUFB, 0, kf);
            vread(Kb, 1, vf);
            qk(kf, s0a, s0b);
            expsum(s1a, l0);
            pv1(vf, s1a, o0);
        } else {
            kread(Kb, 1, kf); vread(Kb, 0, vf);
            qk(kf, s1a, s1b);
            expsum(s0a, l0); expsum(s0b, l1);
            pv1(vf, s0a, o0); pv1(vf, s0b, o1);
            kread(lds + slot1 * AT_BUFB, 0, kf);
            vread(Kb, 1, vf);
            qk(kf, s0a, s0b);
            expsum(s1a, l0); expsum(s1b, l1);
            pv1(vf, s1a, o0); pv1(vf, s1b, o1);
        }
        lstore(slot2, ks, vs);
        __syncthreads();
        slot = slot1;
    };
    if (DIFF) { for (int t = a.t0; t < a.t1; ++t) step(t, kregA, vregA, kregA, vregA, 0, 0); }
    else {
        int t = a.t0;
        if (wrider)
            for (int j = 0; j < AT_NWT; ++j, t += 2) { step(t, kregB, vregB, kregA, vregA, 1, j); step(t + 1, kregA, vregA, kregB, vregB, 2, j); }
        for (; t < a.t1; t += 2) {
            step(t, kregB, vregB, kregA, vregA, 0, 0);
            if (t + 1 < a.t1) step(t + 1, kregA, vregA, kregB, vregB, 0, 0);
        }
    }
    float lt0 = l0[0] + l0[1] + l0[2] + l0[3];
    lt0 += __shfl_xor(lt0, 32);
    bf16_t* op = a.out + (size_t)(wid * 32 + r) * 1024 + 4 * h;
    if (!DIFF) {
        const float rl = 1.0f / lt0;
#pragma unroll
        for (int d = 0; d < 2; ++d)
#pragma unroll
            for (int g = 0; g < 4; ++g) { f32x4 v = {o0[d][4 * g] * rl, o0[d][4 * g + 1] * rl, o0[d][4 * g + 2] * rl, o0[d][4 * g + 3] * rl}; store8(op + 32 * d + 8 * g, v); }
    } else {
        float lt1 = l1[0] + l1[1] + l1[2] + l1[3];
        lt1 += __shfl_xor(lt1, 32);
        const float r0 = 1.0f / lt0, r1 = a.lam / lt1;
        float ss = 0.f;
#pragma unroll
        for (int d = 0; d < 2; ++d)
#pragma unroll
            for (int i = 0; i < 16; ++i) { const float v = o0[d][i] * r0 - o1[d][i] * r1; o0[d][i] = v; ss += v * v; }
        ss += __shfl_xor(ss, 32);
        const float rinv = rsqrtf(ss * (1.0f / 64.0f) + EPS) * a.oscale;
        f32x4 ggv[2][4];
#pragma unroll
        for (int d = 0; d < 2; ++d)
#pragma unroll
            for (int g = 0; g < 4; ++g) ggv[d][g] = *(const f32x4*)(a.subg + 32 * d + 8 * g + 4 * h);
        asm volatile("" : "+v"(ggv[0][0]), "+v"(ggv[1][3]));
#pragma unroll
        for (int d = 0; d < 2; ++d)
#pragma unroll
            for (int g = 0; g < 4; ++g) { const f32x4 gg = ggv[d][g];
                f32x4 v = {o0[d][4 * g] * rinv * gg[0], o0[d][4 * g + 1] * rinv * gg[1], o0[d][4 * g + 2] * rinv * gg[2], o0[d][4 * g + 3] * rinv * gg[3]}; store8(op + 32 * d + 8 * g, v); }
    }
}

constexpr int A8_PITCH = 80;
constexpr int A8_VOFF = 64 * A8_PITCH;
DI f32x16 mfma8(v8i a, v8i b, f32x16 c) { return __builtin_amdgcn_mfma_scale_f32_32x32x64_f8f6f4(a, b, c, 0, 0, 0, 0, 0, 0); }
DI u32x2 bf8_to_fp8(u32x4 v) {
    int d0 = 0, d1 = 0;
    d0 = __builtin_amdgcn_cvt_pk_fp8_f32(bflo(v.x), bfhi(v.x), d0, false); d0 = __builtin_amdgcn_cvt_pk_fp8_f32(bflo(v.y), bfhi(v.y), d0, true);
    d1 = __builtin_amdgcn_cvt_pk_fp8_f32(bflo(v.z), bfhi(v.z), d1, false); d1 = __builtin_amdgcn_cvt_pk_fp8_f32(bflo(v.w), bfhi(v.w), d1, true);
    return (u32x2){(unsigned)d0, (unsigned)d1};
}
DI void attn_unit_a8(unsigned char* lds, const AttnArgs& a) {
    int tid = threadIdx.x; asm volatile("" : "+v"(tid));
    const int lane = tid & 63, r = lane & 31, h = lane >> 5; const int wid = __builtin_amdgcn_readfirstlane(tid >> 6);
    v8i qf8;
    { const bf16_t* qp = a.q + (size_t)(wid * 32 + r) * 256 + 32 * h;
      const u32x4 q0 = *(const u32x4*)qp, q1 = *(const u32x4*)(qp + 8), q2 = *(const u32x4*)(qp + 16), q3 = *(const u32x4*)(qp + 24);
      const u32x2 c0 = bf8_to_fp8(q0), c1 = bf8_to_fp8(q1), c2 = bf8_to_fp8(q2), c3 = bf8_to_fp8(q3);
      qf8 = (v8i){(int)c0.x, (int)c0.y, (int)c1.x, (int)c1.y, (int)c2.x, (int)c2.y, (int)c3.x, (int)c3.y}; }
    const int lrow = tid >> 3, lch = tid & 7;
    const bf16_t* vsrc = a.vt + (size_t)lrow * KEYS + 8 * lch;
    const int ldk = lrow * A8_PITCH + 8 * lch;
    const int ldv = A8_VOFF + lrow * A8_PITCH + (lch >> 2) * 16 + (lch & 3) * 4;
    const int koff = r * A8_PITCH + 32 * h, voff = A8_VOFF + r * A8_PITCH + 32 * h;
    f32x16 o0[2]; o0[0] = (f32x16){}; o0[1] = (f32x16){};
    f32x4 l0 = {0.f, 0.f, 0.f, 0.f};
    u32x4 kregA, vregA, kregB, vregB;
    auto gload = [&](int t, u32x4& kreg, u32x4& vreg) __attribute__((always_inline)) {
        const bf16_t* kp = (t < 64) ? a.klat + (size_t)(t * 64 + lrow) * a.kpitch : a.kctx + (size_t)((t - 64) * 64 + lrow) * a.kpitch;
        kreg = *(const u32x4*)(kp + 8 * lch);
        vreg = *(const u32x4*)(vsrc + (size_t)t * 64);
    };
    auto lstore = [&](int slot, const u32x4& kreg, const u32x4& vreg) __attribute__((always_inline)) { unsigned char* b = lds + slot * AT_BUFB;
        *(u32x2*)(b + ldk) = bf8_to_fp8(kreg); const u32x2 v8 = bf8_to_fp8(vreg); *(unsigned*)(b + ldv) = v8.x; *(unsigned*)(b + ldv + 32) = v8.y; };
    auto rd32 = [&](const unsigned char* p) __attribute__((always_inline)) -> v8i { const u32x4 lo = *(const u32x4*)p, hi = *(const u32x4*)(p + 16);
        return (v8i){(int)lo.x, (int)lo.y, (int)lo.z, (int)lo.w, (int)hi.x, (int)hi.y, (int)hi.z, (int)hi.w}; };
    auto kread = [&](const unsigned char* Kb, int hh) __attribute__((always_inline)) -> v8i { return rd32(Kb + koff + hh * 32 * A8_PITCH); };
    auto vread = [&](const unsigned char* Vb, int dblk) __attribute__((always_inline)) -> v8i { return rd32(Vb + voff + dblk * 32 * A8_PITCH); };
    const f32x16 cinit = (f32x16){} - 4.0f;
    auto expsum = [&](f32x16& sc) __attribute__((always_inline)) {
#pragma unroll
        for (int i = 0; i < 16; ++i) sc[i] = __builtin_amdgcn_exp2f(sc[i]);
#pragma unroll
        for (int i = 0; i < 4; ++i) l0 += (f32x4){sc[4 * i], sc[4 * i + 1], sc[4 * i + 2], sc[4 * i + 3]};
    };
    auto pack8 = [&](const f32x16& s0, const f32x16& s1) __attribute__((always_inline)) -> v8i { v8i p;
#pragma unroll
        for (int g = 0; g < 4; ++g) { p[g] = (int)pk4_fp8(s0[4 * g], s0[4 * g + 1], s0[4 * g + 2], s0[4 * g + 3]); p[4 + g] = (int)pk4_fp8(s1[4 * g], s1[4 * g + 1], s1[4 * g + 2], s1[4 * g + 3]); }
        return p; };
    f32x4 wq[4];
    const int wn4 = (tid & 63) * 4;
    constexpr int WPITCH = 36;
    auto w_decode = [&](int j, const float*& src, unsigned char*& dst, int& ld, int& n0, int& k0, bool& gu) __attribute__((always_inline)) {
        const int g = (j >> 2) * 512 + a.wl, e = g / 96, rr = g - e * 96; KParamsPtr kp = kparams();
        if (rr < 64) { src = kp->w_gu + ((size_t)a.wli * NE + e) * (1024 * 2048); dst = kp->ws + WS_WGU + (size_t)a.wli * SZ_WGU + (size_t)e * 2048 * 1024; ld = 2048; n0 = (rr & 7) * 256; k0 = ((rr >> 3) * 4 + (j & 3)) * 32; gu = true; }
        else { const int q = rr - 64; src = kp->w_dn + ((size_t)a.wli * NE + e) * (1024 * 1024); dst = kp->ws + WS_WDN + (size_t)a.wli * SZ_WDN + (size_t)e * 1024 * 1024; ld = 1024; n0 = (q & 3) * 256; k0 = ((q >> 2) * 4 + (j & 3)) * 32; gu = false; } };
    auto w_issue = [&](int j) __attribute__((always_inline)) { const float* src; unsigned char* dst; int ld, n0, k0; bool gu; w_decode(j, src, dst, ld, n0, k0, gu);
        const float* p = src + (size_t)(k0 + 4 * wid) * ld + n0 + wn4;
        wq[0] = __builtin_nontemporal_load((const f32x4*)p); wq[1] = __builtin_nontemporal_load((const f32x4*)(p + ld));
        wq[2] = __builtin_nontemporal_load((const f32x4*)(p + (size_t)2 * ld)); wq[3] = __builtin_nontemporal_load((const f32x4*)(p + (size_t)3 * ld)); };
    auto w_cvt = [&]() __attribute__((always_inline)) { unsigned char* t8 = lds + AT_WT + wn4 * WPITCH + 4 * wid;
#pragma unroll
        for (int j = 0; j < 4; ++j) *(unsigned*)(t8 + j * WPITCH) = pk4_fp8(wq[0][j] * W8_SCALE, wq[1][j] * W8_SCALE, wq[2][j] * W8_SCALE, wq[3][j] * W8_SCALE); };
    auto w_store = [&](int j) __attribute__((always_inline)) { const float* src; unsigned char* dst; int ld, n0, k0; bool gu; w_decode(j, src, dst, ld, n0, k0, gu);
        const int col = tid >> 1, half = tid & 1, n = n0 + col; const int p = gu ? fwd_gu(n) : fwd_dn(n);
        const unsigned* t = (const unsigned*)(lds + AT_WT + col * WPITCH + 16 * half);
        *(u32x4*)(dst + (size_t)p * 1024 + k0 + 16 * half) = (u32x4){t[0], t[1], t[2], t[3]}; };
    const bool wrider = a.wl >= 0;
    if (wrider) w_issue(0);
    gload(a.t0, kregA, vregA); gload(a.t0 + 1 < a.t1 ? a.t0 + 1 : a.t0, kregB, vregB);
    lstore(0, kregA, vregA); lstore(1, kregB, vregB);
    __syncthreads();
    asm volatile("" : "+v"(qf8));
    if (a.t0 + 2 < a.t1) gload(a.t0 + 2, kregA, vregA);
    f32x16 sx0, sx1, sy0, sy1;
    sx0 = mfma8(kread(lds, 0), qf8, cinit); sx1 = mfma8(kread(lds, 1), qf8, cinit);
    int slot = 0;
    auto step = [&](int t, u32x4& kl, u32x4& vl, const u32x4& ks, const u32x4& vs, f32x16& c0, f32x16& c1, f32x16& n0, f32x16& n1, const int hk, const int wj) __attribute__((always_inline)) {
        const int slot1 = slot == 2 ? 0 : slot + 1, slot2 = slot1 == 2 ? 0 : slot1 + 1;
        if (hk == 1) { w_cvt(); w_issue(wj + 1 < AT_NWT ? wj + 1 : AT_NWT - 1); }
        if (hk == 2) w_store(wj);
        { const int tn = t + 3; gload(tn < a.t1 ? tn : a.t1 - 1, kl, vl); }
        const unsigned char* Kb = lds + slot * AT_BUFB; const unsigned char* Kn = lds + slot1 * AT_BUFB;
        const v8i k0 = kread(Kn, 0), k1 = kread(Kn, 1), v0 = vread(Kb, 0), v1 = vread(Kb, 1);
        n0 = mfma8(k0, qf8, cinit); n1 = mfma8(k1, qf8, cinit);
        expsum(c0); expsum(c1);
        const v8i P = pack8(c0, c1);
        o0[0] = mfma8(v0, P, o0[0]); o0[1] = mfma8(v1, P, o0[1]);
        lstore(slot2, ks, vs);
        __syncthreads();
        slot = slot1;
    };
    {
        int t = a.t0;
        if (wrider)
            for (int j = 0; j < AT_NWT; ++j, t += 2) { step(t, kregB, vregB, kregA, vregA, sx0, sx1, sy0, sy1, 1, j); step(t + 1, kregA, vregA, kregB, vregB, sy0, sy1, sx0, sx1, 2, j); }
        for (; t < a.t1; t += 2) {
            step(t, kregB, vregB, kregA, vregA, sx0, sx1, sy0, sy1, 0, 0);
            if (t + 1 < a.t1) step(t + 1, kregA, vregA, kregB, vregB, sy0, sy1, sx0, sx1, 0, 0);
            else { sx0 = sy0; sx1 = sy1; }
        }
    }
    float lt0 = l0[0] + l0[1] + l0[2] + l0[3];
    lt0 += __shfl_xor(lt0, 32);
    bf16_t* op = a.out + (size_t)(wid * 32 + r) * 1024 + 4 * h;
    const float rl = 1.0f / lt0;
#pragma unroll
    for (int d = 0; d < 2; ++d)
#pragma unroll
        for (int g = 0; g < 4; ++g) { f32x4 v = {o0[d][4 * g] * rl, o0[d][4 * g + 1] * rl, o0[d][4 * g + 2] * rl, o0[d][4 * g + 3] * rl}; store8(op + 32 * d + 8 * g, v); }
}

constexpr int FF_PITCH = 272;
constexpr int FF1_A = 0, FF1_B = 128 * FF_PITCH;
constexpr int FF3_A = 0, FF3_B = 64 * FF_PITCH;
DI void fft_load_a(unsigned char* lds, const bf16_t* M, int rows) {
    for (int idx = ld_tid(); idx < rows * 16; idx += 512) { const int r = idx >> 4, c = idx & 15; *(u32x4*)(lds + r * FF_PITCH + 16 * c) = *(const u32x4*)(M + r * 128 + 8 * c); }
    __syncthreads();
}
DI void fft1_unit(unsigned char* lds, const unsigned char* ws, int unit) {
    int tid = threadIdx.x; asm volatile("" : "+v"(tid));
    const int lane = tid & 63, r = lane & 31, h = lane >> 5, w = tid >> 6, b = unit >> 6, cq = unit & 63;
    const bf16_t* FT = (const bf16_t*)(ws + WS_FT) + (size_t)(b * 256 + 4 * cq) * 8192;
    unsigned char* Bt = lds + FF1_B;
    { u32x4 v[8];
#pragma unroll
      for (int j = 0; j < 8; ++j) { const int idx = tid + 512 * j, t2c = idx & 7, t1 = (idx >> 3) & 63, part = (idx >> 9) & 1, chl = idx >> 10;
          v[j] = *(const u32x4*)(FT + (size_t)chl * 8192 + part * 4096 + 64 * t1 + 8 * t2c); }
#pragma unroll
      for (int j = 0; j < 8; ++j) { const int idx = tid + 512 * j, t2c = idx & 7, t1 = (idx >> 3) & 63, part = (idx >> 9) & 1, chl = idx >> 10;
          unsigned char* d = Bt + (chl * 64 + 8 * t2c) * FF_PITCH + (part * 64 + t1) * 2;
#pragma unroll
          for (int e = 0; e < 4; ++e) { *(bf16_t*)(d + (2 * e) * FF_PITCH) = (bf16_t)(v[j][e] & 0xffffu); *(bf16_t*)(d + (2 * e + 1) * FF_PITCH) = (bf16_t)(v[j][e] >> 16); } } }
    __syncthreads();
    f32x16 acc[4];
#pragma unroll
    for (int rb = 0; rb < 4; ++rb) acc[rb] = (f32x16){};
#pragma unroll
    for (int ks = 0; ks < 8; ++ks) { const bf16x8 bf = *(const bf16x8*)(Bt + (32 * w + r) * FF_PITCH + 32 * ks + 16 * h);
#pragma unroll
        for (int rb = 0; rb < 4; ++rb) acc[rb] = mfma32(*(const bf16x8*)(lds + FF1_A + (32 * rb + r) * FF_PITCH + 32 * ks + 16 * h), bf, acc[rb]); }
    const int t2 = 32 * (w & 1) + r, ch = 4 * cq + (w >> 1);
    const float* TW = (const float*)(ws + WS_TW); bf16_t* Y2 = (bf16_t*)(const_cast<unsigned char*>(ws) + WS_Y2);
    f32x2 twv[2][16];
#pragma unroll
    for (int rb = 0; rb < 2; ++rb)
#pragma unroll
        for (int i = 0; i < 16; ++i) { const int k1 = 32 * rb + (i & 3) + 8 * (i >> 2) + 4 * h; twv[rb][i] = *(const f32x2*)(TW + 2 * (k1 * 64 + t2)); }
    asm volatile("" : "+v"(twv[0][0]), "+v"(twv[0][15]), "+v"(twv[1][0]), "+v"(twv[1][15]));
#pragma unroll
    for (int rb = 0; rb < 2; ++rb)
#pragma unroll
        for (int i = 0; i < 16; ++i) { const int k1 = 32 * rb + (i & 3) + 8 * (i >> 2) + 4 * h;
            const f32x2 tw = twv[rb][i]; const float re = acc[rb][i], im = acc[2 + rb][i];
            bf16_t* y = Y2 + ((size_t)((b * 64 + k1) * 256 + ch)) * 128 + t2;
            const unsigned pr = pk2(re * tw.x + im * tw.y, im * tw.x - re * tw.y);
            y[0] = (bf16_t)(pr & 0xffffu); y[64] = (bf16_t)(pr >> 16); }
    __syncthreads();
}
DI void fft3_unit(unsigned char* lds, const unsigned char* ws, int unit) {
    int tid = threadIdx.x; asm volatile("" : "+v"(tid));
    const int lane = tid & 63, r = lane & 31, h = lane >> 5, w = tid >> 6, b = unit >> 6, k1 = unit & 63;
    const bf16_t* Y2 = (const bf16_t*)(ws + WS_Y2) + (size_t)unit * 256 * 128;
    unsigned char* Bt = lds + FF3_B;
    { u32x4 v[8];
#pragma unroll
      for (int j = 0; j < 8; ++j) { const int idx = tid + 512 * j; v[j] = *(const u32x4*)(Y2 + (size_t)idx * 8); }
#pragma unroll
      for (int j = 0; j < 8; ++j) { const int idx = tid + 512 * j; *(u32x4*)(Bt + (idx >> 4) * FF_PITCH + 16 * (idx & 15)) = v[j]; } }
    __syncthreads();
    f32x16 acc[2];
    acc[0] = (f32x16){}; acc[1] = (f32x16){};
#pragma unroll
    for (int ks = 0; ks < 8; ++ks) { const bf16x8 bf = *(const bf16x8*)(Bt + (32 * w + r) * FF_PITCH + 32 * ks + 16 * h);
#pragma unroll
        for (int rb = 0; rb < 2; ++rb) acc[rb] = mfma32(*(const bf16x8*)(lds + FF3_A + (32 * rb + r) * FF_PITCH + 32 * ks + 16 * h), bf, acc[rb]); }
    bf16_t* CAT = (bf16_t*)(const_cast<unsigned char*>(ws) + WS_CAT) + (size_t)(b * SEQ + k1) * 1024 + 512 + 32 * w + r;
#pragma unroll
    for (int rb = 0; rb < 2; ++rb)
#pragma unroll
        for (int i = 0; i < 16; ++i) { const int k2 = 32 * rb + (i & 3) + 8 * (i >> 2) + 4 * h; CAT[(size_t)k2 * 64 * 1024] = (bf16_t)(pk2(acc[rb][i], 0.f) & 0xffffu); }
    __syncthreads();
}

DI void load_row(const float* xr, int lane, f32x4 (&v)[4]) {
    v[0] = *(const f32x4*)(xr + 8 * lane); v[1] = *(const f32x4*)(xr + 8 * lane + 4); v[2] = *(const f32x4*)(xr + 512 + 8 * lane); v[3] = *(const f32x4*)(xr + 512 + 8 * lane + 4);
}
DI void load_row_bf(const bf16_t* xr, int lane, f32x4 (&v)[4]) {
    const u32x4 a = *(const u32x4*)(xr + 8 * lane), b = *(const u32x4*)(xr + 512 + 8 * lane);
    v[0] = (f32x4){bflo(a[0]), bfhi(a[0]), bflo(a[1]), bfhi(a[1])}; v[1] = (f32x4){bflo(a[2]), bfhi(a[2]), bflo(a[3]), bfhi(a[3])};
    v[2] = (f32x4){bflo(b[0]), bfhi(b[0]), bflo(b[1]), bfhi(b[1])}; v[3] = (f32x4){bflo(b[2]), bfhi(b[2]), bflo(b[3]), bfhi(b[3])};
}
DI void modnorm_row(f32x4 (&v)[4], int lane, const float* g, const float* sh, const float* sc) {
    float ss = 0.f;
#pragma unroll
    for (int j = 0; j < 4; ++j)
#pragma unroll
        for (int i = 0; i < 4; ++i) ss += v[j][i] * v[j][i];
    ss = wave_sum(ss);
    const float rinv = rsqrtf(ss * (1.0f / 1024.0f) + EPS);
#pragma unroll
    for (int j = 0; j < 4; ++j) { const int k = (j >> 1) * 512 + 8 * lane + 4 * (j & 1);
        const f32x4 gg = *(const f32x4*)(g + k), s1 = *(const f32x4*)(sc + k), s0 = *(const f32x4*)(sh + k);
        v[j] = v[j] * rinv * gg * (s1 + 1.0f) + s0; }
}
DI void store_row_bf16(bf16_t* hr, int lane, const f32x4 (&v)[4]) { store16(hr + 8 * lane, v[0], v[1]); store16(hr + 512 + 8 * lane, v[2], v[3]); }

DI void phase_norm1(const Params& P, bf16_t* H, const float* mod0, int G) {
    const int tid_ = ld_tid(); const int lane = tid_ & 63, gw = blockIdx.x * 8 + (tid_ >> 6);
    for (int row = gw; row < NTOK; row += G * 8) {
        const float* xr = row < NLAT ? P.x + (size_t)row * 1024 : P.ctx + (size_t)(row - NLAT) * 1024;
        const float* md = mod0 + (row < NLAT ? (row >> 12) : 8) * 6144;
        f32x4 v[4]; load_row(xr, lane, v);
        modnorm_row(v, lane, P.norm1_g, md, md + 1024);
        store_row_bf16(H + (size_t)row * 1024, lane, v);
    }
}

DI void conv_unit(unsigned char* lds, int seqrow, int L, int t0, const bf16_t* BU, const bf16_t* BG, const float* cw, const float* cb, const float* lg, const float* lb, bf16_t* CAT) {
    float* z = (float*)lds;
    int tid = threadIdx.x; asm volatile("" : "+v"(tid));
    { u32x4 uv[6], gv[6];
#pragma unroll
      for (int q = 0; q < 6; ++q) { const int idx = tid + 512 * q, j = idx >> 5, c8 = (idx & 31) * 8, t = t0 - 15 + j; const bool ok = idx < 94 * 32 && t >= 0 && t < L;
          const size_t off = (size_t)(seqrow + (ok ? t : t0)) * 256 + c8; uv[q] = *(const u32x4*)(BU + off); gv[q] = *(const u32x4*)(BG + off); }
#pragma unroll
      for (int q = 0; q < 6; ++q) { const int idx = tid + 512 * q, j = idx >> 5, c8 = (idx & 31) * 8, t = t0 - 15 + j;
          if (idx < 94 * 32) { const bool ok = t >= 0 && t < L; float o[8];
#pragma unroll
              for (int e = 0; e < 4; ++e) { o[2 * e] = ok ? bflo(uv[q][e]) * sigmoidf_(bflo(gv[q][e])) : 0.f; o[2 * e + 1] = ok ? bfhi(uv[q][e]) * sigmoidf_(bfhi(gv[q][e])) : 0.f; }
              *(f32x4*)(z + j * 256 + c8) = (f32x4){o[0], o[1], o[2], o[3]}; *(f32x4*)(z + j * 256 + c8 + 4) = (f32x4){o[4], o[5], o[6], o[7]}; } } }
    __syncthreads();
    const int c = tid & 255, half = tid >> 8;
    float acc[32];
    { const float b = cb[c];
#pragma unroll
      for (int i = 0; i < 32; ++i) acc[i] = b; }
    { float wj[31], zr[62];
#pragma unroll
      for (int j = 0; j < 31; ++j) wj[j] = cw[j * 256 + c];
#pragma unroll
      for (int q = 0; q < 62; ++q) zr[q] = z[(32 * half + q) * 256 + c];
#pragma unroll
      for (int j = 0; j < 31; ++j)
#pragma unroll
          for (int i = 0; i < 32; ++i) acc[i] += wj[j] * zr[i + j]; }
    __syncthreads();
#pragma unroll
    for (int i = 0; i < 32; ++i) z[(32 * half + i) * 256 + c] = acc[i];
    __syncthreads();
    const int lane = tid & 63, wv = tid >> 6;
    const f32x4 g4 = *(const f32x4*)(lg + 4 * lane), b4 = *(const f32x4*)(lb + 4 * lane);
    for (int tt = wv; tt < 64; tt += 8) {
        const f32x4 v = *(const f32x4*)(z + tt * 256 + 4 * lane);
        const float mean = wave_sum(v[0] + v[1] + v[2] + v[3]) * (1.0f / 256.0f);
        const f32x4 d = v - mean;
        const float var = wave_sum(d[0] * d[0] + d[1] * d[1] + d[2] * d[2] + d[3] * d[3]) * (1.0f / 256.0f);
        const f32x4 y = d * rsqrtf(var + EPS) * g4 + b4;
        f32x4 o;
#pragma unroll
        for (int e = 0; e < 4; ++e) o[e] = y[e] * sigmoidf_(y[e]);
        store8(CAT + (size_t)(seqrow + t0 + tt) * 1024 + 256 + 4 * lane, o);
    }
    __syncthreads();
}

constexpr int RT_CH = 136;
constexpr int RT_HS = 0, RT_PART = 16 * 1028 * 4, RT_LOG = RT_PART + 8 * 16 * 32 * 4, RT_HIST = RT_LOG + 144 * 33 * 4, RT_BASE = RT_HIST + 128, RT_RE = RT_BASE + 128, RT_RP = RT_RE + RT_CH * 16, RT_RG = RT_RP + RT_CH * 16;
DI void phase_router(unsigned char* lds, const Params& P, int li, const bf16_t* X1, unsigned char* H8, const float* modl, unsigned* cnt, int* tok_e, int* tok_pos, float* tok_gate, int* tok_list, int G, int ntok, int chsz) {
    const int tid = ld_tid(), lane = tid & 63, w = tid >> 6;
    float* Hs = (float*)(lds + RT_HS); float* part = (float*)(lds + RT_PART); float* logit = (float*)(lds + RT_LOG);
    int* hist = (int*)(lds + RT_HIST); int* base = (int*)(lds + RT_BASE); int* rec_e = (int*)(lds + RT_RE); int* rec_p = (int*)(lds + RT_RP); float* rec_g = (float*)(lds + RT_RG);
    const float* rw = P.router_w + (size_t)li * 1024 * 32; const float* rb = P.router_b + li * 32; const float* g2n = P.norm2_g + li * 1024;
    float wreg[32][2];
#pragma unroll
    for (int s = 0; s < 32; ++s)
#pragma unroll
        for (int hf = 0; hf < 2; ++hf) wreg[s][hf] = rw[(size_t)(128 * w + 4 * s + (lane >> 4)) * 32 + 16 * hf + (lane & 15)];
    f32x4 ma[4], mb[4]; int cur_b9 = -1;
    auto load_mod = [&](int b9) __attribute__((always_inline)) { const float* md = modl + b9 * 6144;
#pragma unroll
        for (int j = 0; j < 4; ++j) { const int k = (j >> 1) * 512 + 8 * lane + 4 * (j & 1); ma[j] = *(const f32x4*)(g2n + k) * (*(const f32x4*)(md + 4 * 1024 + k) + 1.0f); mb[j] = *(const f32x4*)(md + 3 * 1024 + k); }
        cur_b9 = b9; };
    for (int ch = blockIdx.x; ch * chsz < ntok; ch += G) {
        const int c0 = ch * chsz, ngrp = (chsz + 15) / 16;
        if (tid < 32) hist[tid] = 0;
        u32x4 ra[2], rbv[2];
        auto fetch = [&](int g) __attribute__((always_inline)) {
#pragma unroll
            for (int rr = 0; rr < 2; ++rr) { const int tl = 16 * g + 2 * w + rr; const bf16_t* xr = X1 + (size_t)(c0 + (tl < chsz ? tl : 0)) * 1024;
                ra[rr] = *(const u32x4*)(xr + 8 * lane); rbv[rr] = *(const u32x4*)(xr + 512 + 8 * lane); } };
        fetch(0);
        __syncthreads();
        for (int g = 0; g < ngrp; ++g) {
#pragma unroll
            for (int rr = 0; rr < 2; ++rr) {
                const int tl = 16 * g + 2 * w + rr, tok = c0 + tl; float* hs = Hs + (2 * w + rr) * 1028;
                f32x4 v[4];
                if (tl < chsz) {
                    const u32x4 a = ra[rr], b = rbv[rr];
                    v[0] = (f32x4){bflo(a[0]), bfhi(a[0]), bflo(a[1]), bfhi(a[1])}; v[1] = (f32x4){bflo(a[2]), bfhi(a[2]), bflo(a[3]), bfhi(a[3])};
                    v[2] = (f32x4){bflo(b[0]), bfhi(b[0]), bflo(b[1]), bfhi(b[1])}; v[3] = (f32x4){bflo(b[2]), bfhi(b[2]), bflo(b[3]), bfhi(b[3])};
                    const int b9 = tok < NLAT ? (tok >> 12) : 8; if (b9 != cur_b9) load_mod(b9);
                    float ss = 0.f;
#pragma unroll
                    for (int j = 0; j < 4; ++j)
#pragma unroll
                        for (int i = 0; i < 4; ++i) ss += v[j][i] * v[j][i];
                    ss = wave_sum(ss);
                    const float rinv = __builtin_amdgcn_rsqf(ss * (1.0f / 1024.0f) + EPS);
#pragma unroll
                    for (int j = 0; j < 4; ++j) v[j] = v[j] * rinv * ma[j] + mb[j];
                    { unsigned char* hr = H8 + (size_t)tok * 1024; u32x2 w0, w1;
                      w0.x = pk4_fp8(clamp448(v[0][0]), clamp448(v[0][1]), clamp448(v[0][2]), clamp448(v[0][3])); w0.y = pk4_fp8(clamp448(v[1][0]), clamp448(v[1][1]), clamp448(v[1][2]), clamp448(v[1][3]));
                      w1.x = pk4_fp8(clamp448(v[2][0]), clamp448(v[2][1]), clamp448(v[2][2]), clamp448(v[2][3])); w1.y = pk4_fp8(clamp448(v[3][0]), clamp448(v[3][1]), clamp448(v[3][2]), clamp448(v[3][3]));
                      *(u32x2*)(hr + 8 * lane) = w0; *(u32x2*)(hr + 512 + 8 * lane) = w1; } }
                else {
#pragma unroll
                    for (int j = 0; j < 4; ++j) v[j] = (f32x4){0.f, 0.f, 0.f, 0.f}; }
                *(f32x4*)(hs + 8 * lane) = v[0]; *(f32x4*)(hs + 8 * lane + 4) = v[1]; *(f32x4*)(hs + 512 + 8 * lane) = v[2]; *(f32x4*)(hs + 512 + 8 * lane + 4) = v[3];
            }
            if (g + 1 < ngrp) fetch(g + 1);
            __syncthreads();
            f32x4 a0 = {0.f, 0.f, 0.f, 0.f}, a1 = {0.f, 0.f, 0.f, 0.f};
            { const float* hp = Hs + (lane & 15) * 1028 + 128 * w + (lane >> 4);
#pragma unroll
              for (int s = 0; s < 32; ++s) { const float av = hp[4 * s];
                  a0 = __builtin_amdgcn_mfma_f32_16x16x4f32(av, wreg[s][0], a0, 0, 0, 0); a1 = __builtin_amdgcn_mfma_f32_16x16x4f32(av, wreg[s][1], a1, 0, 0, 0); } }
#pragma unroll
            for (int i = 0; i < 4; ++i) { part[(w * 16 + 4 * (lane >> 4) + i) * 32 + (lane & 15)] = a0[i]; part[(w * 16 + 4 * (lane >> 4) + i) * 32 + 16 + (lane & 15)] = a1[i]; }
            __syncthreads();
            { const int tk = tid >> 5, e = tid & 31; float s = rb[e];
#pragma unroll
              for (int ww = 0; ww < 8; ++ww) s += part[(ww * 16 + tk) * 32 + e];
              logit[(16 * g + tk) * 33 + e] = s; }
        }
        __syncthreads();
        if (tid < chsz) {
            float v0 = -INFINITY, v1 = -INFINITY, v2 = -INFINITY, v3 = -INFINITY; int e0 = 0, e1 = 0, e2 = 0, e3 = 0;
            for (int e = 0; e < 32; ++e) { const float x = logit[tid * 33 + e];
                if (x > v0) { v3 = v2; e3 = e2; v2 = v1; e2 = e1; v1 = v0; e1 = e0; v0 = x; e0 = e; }
                else if (x > v1) { v3 = v2; e3 = e2; v2 = v1; e2 = e1; v1 = x; e1 = e; }
                else if (x > v2) { v3 = v2; e3 = e2; v2 = x; e2 = e; }
                else if (x > v3) { v3 = x; e3 = e; } }
            const float p1 = __expf(v1 - v0), p2 = __expf(v2 - v0), p3 = __expf(v3 - v0), inv = 1.0f / (1.0f + p1 + p2 + p3);
            const int tl = tid;
            rec_e[tl * 4 + 0] = e0; rec_e[tl * 4 + 1] = e1; rec_e[tl * 4 + 2] = e2; rec_e[tl * 4 + 3] = e3;
            rec_g[tl * 4 + 0] = inv; rec_g[tl * 4 + 1] = p1 * inv; rec_g[tl * 4 + 2] = p2 * inv; rec_g[tl * 4 + 3] = p3 * inv;
            rec_p[tl * 4 + 0] = atomicAdd(&hist[e0], 1); rec_p[tl * 4 + 1] = atomicAdd(&hist[e1], 1); rec_p[tl * 4 + 2] = atomicAdd(&hist[e2], 1); rec_p[tl * 4 + 3] = atomicAdd(&hist[e3], 1);
        }
        __syncthreads();
        if (tid < 32) base[tid] = (int)__hip_atomic_fetch_add(cnt + tid, (unsigned)hist[tid], __ATOMIC_RELAXED, __HIP_MEMORY_SCOPE_AGENT);
        __syncthreads();
        for (int idx = tid; idx < chsz * 4; idx += 512) { const int e = rec_e[idx], pos = base[e] + rec_p[idx]; tok_e[c0 * 4 + idx] = e; tok_pos[c0 * 4 + idx] = pos; tok_gate[c0 * 4 + idx] = rec_g[idx];
            tok_list[e * NTOK + pos] = c0 + (idx >> 2); }
        __syncthreads();
    }
}

DI void moe_tables(LAS int* tab, const unsigned* cnt) {
    const int tid = ld_tid();
    if (tid < 64) {
        const int e = tid & 31;
        const int n = tid < 32 ? ((int)__hip_atomic_load(cnt + e, __ATOMIC_RELAXED, __HIP_MEMORY_SCOPE_AGENT) + 255) >> 8 : 0;
        int incl = n;
#pragma unroll
        for (int o = 1; o < 32; o <<= 1) { const int v = __shfl_up(incl, o); if (tid >= o) incl += v; }
        const int excl = incl - n;
        if (tid < 32) { tab[32 + e] = excl * 256;
#pragma nounroll
            for (int j = 0; j < n; ++j) if (excl + j < MAXMT) tab[64 + excl + j] = e;
            if (tid == 31) tab[0] = incl < MAXMT ? incl : MAXMT; }
    }
    __syncthreads();
}
DI void phase_scatter(const LAS int* tab, const unsigned char* H8, unsigned char* XP, const int* tok_e, const int* tok_pos, int* tok_slot, int G, int ntok) {
    const int tid_ = ld_tid(); const int lane = tid_ & 63, gw = blockIdx.x * 8 + (tid_ >> 6);
    for (int tok = gw; tok < ntok; tok += G * 8) {
        int slot = 0;
        if (lane < 4) { slot = tab[32 + tok_e[tok * 4 + lane]] + tok_pos[tok * 4 + lane]; tok_slot[tok * 4 + lane] = slot; }
        const u32x4 a = *(const u32x4*)(H8 + (size_t)tok * 1024 + 16 * lane);
#pragma unroll
        for (int k = 0; k < 4; ++k) { const int s = __shfl(slot, k); *(u32x4*)(XP + (size_t)s * 1024 + 16 * lane) = a; }
    }
}
DI void phase_combine(const Params& P, int li, const bf16_t* X1, bf16_t* X2, const unsigned char* YB, const LAS int* tab, const int* tok_e, const int* tok_pos, const float* tok_gate, const float* modl, const float* modn, bf16_t* H, int G) {
    const int tid_ = ld_tid(); const int lane = tid_ & 63, gw = blockIdx.x * 8 + (tid_ >> 6);
    const bool last = (li == DEPTH - 1);
    const int N = last ? NLAT : NTOK, S = G * 8;
    int sl[2][4]; float gt[2][4];
    auto ldidx = [&](int tA, int (&s_)[2][4], float (&g_)[2][4]) __attribute__((always_inline)) {
#pragma unroll
        for (int q = 0; q < 2; ++q) { int t = tA + q * S; t = t < N ? t : gw;
            const v4i e4 = *(const v4i*)(tok_e + t * 4), p4 = *(const v4i*)(tok_pos + t * 4); const f32x4 g4 = *(const f32x4*)(tok_gate + t * 4);
#pragma unroll
            for (int k = 0; k < 4; ++k) { s_[q][k] = tab[32 + e4[k]] + p4[k]; g_[q][k] = g4[k]; } } };
    if (gw < N) ldidx(gw, sl, gt);
    for (int tok = gw; tok < N; tok += 2 * S) {
        u32x4 xa[2][2]; u32x2 ya[2][4][2];
#pragma unroll
        for (int q = 0; q < 2; ++q) { int t = tok + q * S; t = t < N ? t : tok;
            xa[q][0] = *(const u32x4*)(X1 + (size_t)t * 1024 + 8 * lane); xa[q][1] = *(const u32x4*)(X1 + (size_t)t * 1024 + 512 + 8 * lane);
#pragma unroll
            for (int k = 0; k < 4; ++k) { ya[q][k][0] = *(const u32x2*)(YB + (size_t)sl[q][k] * 1024 + 8 * lane); ya[q][k][1] = *(const u32x2*)(YB + (size_t)sl[q][k] * 1024 + 512 + 8 * lane); } }
        float gc[2][4];
#pragma unroll
        for (int q = 0; q < 2; ++q)
#pragma unroll
            for (int k = 0; k < 4; ++k) gc[q][k] = gt[q][k];
        { const int nt = tok + 2 * S; ldidx(nt < N ? nt : gw, sl, gt); }
#pragma unroll
        for (int q = 0; q < 2; ++q) { const int t = tok + q * S;
            if (t < N) {
                const int b9 = t < NLAT ? (t >> 12) : 8;
                f32x4 v[4];
                { const u32x4 a = xa[q][0], b = xa[q][1];
                  v[0] = (f32x4){bflo(a[0]), bfhi(a[0]), bflo(a[1]), bfhi(a[1])}; v[1] = (f32x4){bflo(a[2]), bfhi(a[2]), bflo(a[3]), bfhi(a[3])};
                  v[2] = (f32x4){bflo(b[0]), bfhi(b[0]), bflo(b[1]), bfhi(b[1])}; v[3] = (f32x4){bflo(b[2]), bfhi(b[2]), bflo(b[3]), bfhi(b[3])}; }
                f32x4 y[4];
#pragma unroll
                for (int j = 0; j < 4; ++j) y[j] = (f32x4){0.f, 0.f, 0.f, 0.f};
#pragma unroll
                for (int k = 0; k < 4; ++k) { const float g = gc[q][k]; const u32x2 a = ya[q][k][0], b = ya[q][k][1];
                    { const f32x2 p0 = __builtin_amdgcn_cvt_pk_f32_fp8((int)a.x, false), p1 = __builtin_amdgcn_cvt_pk_f32_fp8((int)a.x, true), p2 = __builtin_amdgcn_cvt_pk_f32_fp8((int)a.y, false), p3 = __builtin_amdgcn_cvt_pk_f32_fp8((int)a.y, true);
                      y[0] += g * (f32x4){p0.x, p0.y, p1.x, p1.y}; y[1] += g * (f32x4){p2.x, p2.y, p3.x, p3.y}; }
                    { const f32x2 p0 = __builtin_amdgcn_cvt_pk_f32_fp8((int)b.x, false), p1 = __builtin_amdgcn_cvt_pk_f32_fp8((int)b.x, true), p2 = __builtin_amdgcn_cvt_pk_f32_fp8((int)b.y, false), p3 = __builtin_amdgcn_cvt_pk_f32_fp8((int)b.y, true);
                      y[2] += g * (f32x4){p0.x, p0.y, p1.x, p1.y}; y[3] += g * (f32x4){p2.x, p2.y, p3.x, p3.y}; } }
                const float* g2 = modl + b9 * 6144 + 5 * 1024;
#pragma unroll
                for (int j = 0; j < 4; ++j) { const int k = (j >> 1) * 512 + 8 * lane + 4 * (j & 1); v[j] += *(const f32x4*)(g2 + k) * y[j]; }
                if (last) { float* o = P.out + (size_t)t * 1024; *(f32x4*)(o + 8 * lane) = v[0]; *(f32x4*)(o + 8 * lane + 4) = v[1]; *(f32x4*)(o + 512 + 8 * lane) = v[2]; *(f32x4*)(o + 512 + 8 * lane + 4) = v[3]; }
                else { store_row_bf16(X2 + (size_t)t * 1024, lane, v);
                    const float* md = modn + b9 * 6144;
                    modnorm_row(v, lane, P.norm1_g + (li + 1) * 1024, md, md + 1024);
                    store_row_bf16(H + (size_t)t * 1024, lane, v); }
            } }
    }
}

DI int invperm32(int c) { return 16 * ((c >> 2) & 1) + 4 * (c >> 3) + (c & 3); }
DI int fwd_win(int n) {
    if (n < 256) { const int hd = n >> 6, d = n & 63; return (d >> 5) * 128 + hd * 32 + (d & 31); }
    if (n < 384) { const int m = n - 256, hd = m >> 6, d = m & 63; return 256 + (d >> 5) * 128 + hd * 32 + (d & 31); }
    if (n < 512) { const int m = n - 384, kvh = m >> 6, d = m & 63; return 256 + 128 * (d >> 5) + 32 * (2 + kvh) + invperm32(d & 31); }
    if (n < 1024) { const int m = n - 512; return 512 + (m & ~31) + invperm32(m & 31); }
    if (n < 1280) return -1;
    if (n < 1792) { const int m = n - 1280, T = m >> 8, r = m & 255, hd = r >> 6, c = (r >> 5) & 1, dim = r & 31;
        const int nn = (dim >> 3) & 1, fq = 2 * (dim >> 4) + ((dim >> 2) & 1), i = dim & 3; return 1024 + T * 256 + c * 128 + hd * 32 + 16 * nn + 4 * fq + i; }
    return 4096 + (n - 1792);
}
DI int fwd_gu(int n) { const int bj = n >> 10, r = n & 1023, T = r >> 7, rr = r & 127; return T * 256 + bj * 128 + (rr & ~31) + invperm32(rr & 31); }
DI int fwd_lane16(int c) { const int pn = c >> 8, r = c & 255, wc = r >> 6, fq = (r >> 4) & 3, bj = (r >> 3) & 1, nn = (r >> 2) & 1, i = r & 3; return pn * 256 + bj * 128 + wc * 32 + nn * 16 + fq * 4 + i; }
DI int fwd_dn(int n) { return fwd_lane16(n); }
constexpr int PREP_T_IN = 32 * 8, PREP_T_OUT = 16 * 8, PREP_T_GU = NE * 32 * 8, PREP_T_DN = NE * 16 * 8, PREP_TILES_L = PREP_T_IN + PREP_T_OUT + PREP_T_GU + PREP_T_DN, PREP_TILES_S = PREP_T_IN + PREP_T_OUT;
DI void phase_prep(unsigned char* lds, const Params& P, int G) {
    const int tid = ld_tid(), blk = blockIdx.x;
    unsigned char* ws = P.ws;
    float* lc = (float*)lds; float* ls = lc + 4096;
    for (int j = tid; j < 4096; j += 512) { float s, c; sincospif((float)j * (1.0f / 2048.0f), &s, &c); lc[j] = c; ls[j] = s; }
    __syncthreads();
    {
      if (blk == 0) { bf16_t* M1 = (bf16_t*)(ws + WS_M1);
          for (int idx = tid; idx < 128 * 128; idx += 512) { const int row = idx >> 7, k = idx & 127, ri = row >> 6, k1 = row & 63, part = k >> 6, t1 = k & 63; const int j = ((k1 * t1) & 63) * 64;
              const float c = lc[j], sn = ls[j]; M1[idx] = (bf16_t)(pk2(ri == 0 ? (part == 0 ? c : -sn) : (part == 0 ? -sn : -c), 0.f) & 0xffffu); } }
      if (blk == 1 % G) { bf16_t* M3 = (bf16_t*)(ws + WS_M3);
          for (int idx = tid; idx < 64 * 128; idx += 512) { const int k2 = idx >> 7, k = idx & 127, part = k >> 6, t2 = k & 63; const int j = ((k2 * t2) & 63) * 64;
              M3[idx] = (bf16_t)(pk2((part == 0 ? lc[j] : ls[j]) * (1.0f / 64.0f), 0.f) & 0xffffu); } }
      if (blk == 2 % G) { float* TW = (float*)(ws + WS_TW);
          for (int idx = tid; idx < 64 * 64; idx += 512) { const int k1 = idx >> 6, t2 = idx & 63; const int j = (k1 * t2) & 4095; TW[2 * idx] = lc[j]; TW[2 * idx + 1] = ls[j]; } }
      bf16_t* TC = (bf16_t*)(ws + WS_TC);
      for (int k = blk; k < 256; k += G)
          for (int chunk = tid; chunk < 64; chunk += 512) { const int part = chunk >> 5, t0 = (chunk & 31) * 8; float v[8];
#pragma unroll
              for (int e = 0; e < 8; ++e) { const int j = ((k * (t0 + e)) & 255) * 16; v[e] = (part ? -ls[j] : lc[j]) * (1.0f / 16.0f); }
              store16(TC + (size_t)k * 512 + part * 256 + t0, (f32x4){v[0], v[1], v[2], v[3]}, (f32x4){v[4], v[5], v[6], v[7]}); } }
    { float* wv = (float*)(lds + 32768);
      for (int u = blk; u < DEPTH * 64; u += G) { const int li = u >> 6, k0 = (u & 63) * 16;
          for (int idx = tid; idx < 16 * 64; idx += 512) { const int row = idx >> 6, c4 = (idx & 63) * 4;
              *(f32x4*)(wv + row * 256 + c4) = *(const f32x4*)(P.w_in + ((size_t)li * 1024 + k0 + row) * 2048 + 1024 + c4); }
          __syncthreads();
          const int ch = tid & 255, part = tid >> 8, g = ch >> 6, cp = ch & 63;
          float acc[16];
#pragma unroll
          for (int kk = 0; kk < 16; ++kk) acc[kk] = 0.f;
          const float* tw = part ? ls : lc;
          for (int c = 0; c < 64; ++c) { const float t = tw[((c * cp) & 63) * 64];
#pragma unroll
              for (int kk = 0; kk < 16; ++kk) acc[kk] += wv[kk * 256 + 64 * g + c] * t; }
          bf16_t* d = (bf16_t*)(ws + WS_WCH + (size_t)li * SZ_WCH) + (size_t)(256 + 256 * part + ch) * 1024 + k0;
          store16(d, (f32x4){acc[0], acc[1], acc[2], acc[3]} * 0.125f, (f32x4){acc[4], acc[5], acc[6], acc[7]} * 0.125f);
          store16(d + 8, (f32x4){acc[8], acc[9], acc[10], acc[11]} * 0.125f, (f32x4){acc[12], acc[13], acc[14], acc[15]} * 0.125f);
          __syncthreads(); } }
    { unsigned* tl = (unsigned*)(lds + 32768);
      const int n4 = (tid & 15) * 4, kp = tid >> 4;
      auto decode = [&](int t, const float*& src, int& ld, int& type, int& n0, int& k0, int& li) __attribute__((always_inline)) {
          li = t / PREP_TILES_S; int u = t % PREP_TILES_S;
          if (u < PREP_T_IN) { src = P.w_in + (size_t)li * 1024 * 2048; ld = 2048; type = 0; }
          else { u -= PREP_T_IN; src = P.w_out + (size_t)li * 1024 * 1024; ld = 1024; type = 2; }
          const int nnt = ld >> 6; n0 = (u % nnt) * 64; k0 = (u / nnt) * 128; };
      f32x4 ra[4], rb[4], rc[4];
      auto issue = [&](int t, f32x4 (&r)[4]) __attribute__((always_inline)) { const float* src; int ld, type, n0, k0, li; decode(t, src, ld, type, n0, k0, li);
          const float* p = src + (size_t)(k0 + 2 * kp) * ld + n0 + n4;
          r[0] = *(const f32x4*)p; r[1] = *(const f32x4*)(p + ld); r[2] = *(const f32x4*)(p + (size_t)64 * ld); r[3] = *(const f32x4*)(p + (size_t)65 * ld); };
      int par = 0;
      auto proc = [&](int t, const f32x4 (&cur)[4]) __attribute__((always_inline)) {
          const float* src; int ld, type, n0, k0, li; decode(t, src, ld, type, n0, k0, li);
          unsigned* tlp = tl + par * (64 * 68); par ^= 1;
#pragma unroll
          for (int j = 0; j < 4; ++j) { tlp[(n4 + j) * 68 + kp] = pk2(cur[0][j], cur[1][j]); tlp[(n4 + j) * 68 + 32 + kp] = pk2(cur[2][j], cur[3][j]); }
          __syncthreads();
          const int nl = tid >> 3, c8 = tid & 7, n = n0 + nl;
          int p = type == 0 ? fwd_win(n) : fwd_lane16(n);
          size_t base = type == 0 ? WS_WTOK + (size_t)li * SZ_WTOK : WS_WOUT + (size_t)li * SZ_WOUT;
          if (p >= 4096) { p -= 4096; base = WS_WCH + (size_t)li * SZ_WCH; }
          bf16_t* d = (bf16_t*)(ws + base);
          if (p >= 0) { const u32x4 a = *(const u32x4*)(tlp + nl * 68 + 4 * c8), b = *(const u32x4*)(tlp + nl * 68 + 32 + 4 * c8);
              *(u32x4*)(d + (size_t)p * 1024 + k0 + 8 * c8) = a; *(u32x4*)(d + (size_t)p * 1024 + k0 + 64 + 8 * c8) = b; } };
      constexpr int NTILES = DEPTH * PREP_TILES_S;
      int t = blk;
      if (t < NTILES) issue(t, ra);
      if (t + G < NTILES) issue(t + G, rb);
      while (t < NTILES) {
          if (t + 2 * G < NTILES) issue(t + 2 * G, rc);
          proc(t, ra); t += G; if (t >= NTILES) break;
          if (t + 2 * G < NTILES) issue(t + 2 * G, ra);
          proc(t, rb); t += G; if (t >= NTILES) break;
          if (t + 2 * G < NTILES) issue(t + 2 * G, rb);
          proc(t, rc); t += G;
      }
      __syncthreads();
    }
    { float* sc = (float*)(lds + 32768); float* red = sc + 9216;
      for (int mb = blk; mb < DEPTH * 128; mb += G) { const int li = mb >> 7, cb = mb & 127;
          for (int idx = tid; idx < 9216; idx += 512) { const int r = idx >> 10, k = idx & 1023; const float v = r < 8 ? P.c[r * 1024 + k] : P.c_ctx[k]; sc[idx] = v * sigmoidf_(v); }
          __syncthreads();
          if (tid < 384) { const int cg = tid % 12, ks = tid / 12;
              f32x4 acc[9];
#pragma unroll
              for (int r = 0; r < 9; ++r) acc[r] = (f32x4){0.f, 0.f, 0.f, 0.f};
              for (int k0 = 32 * ks; k0 < 32 * ks + 32; k0 += 8) {
                  f32x4 w4[8];
#pragma unroll
                  for (int j = 0; j < 8; ++j) w4[j] = *(const f32x4*)(P.ada_w + ((size_t)li * 1024 + k0 + j) * 6144 + 48 * cb + 4 * cg);
#pragma unroll
                  for (int j = 0; j < 8; ++j)
#pragma unroll
                      for (int r = 0; r < 9; ++r) acc[r] += sc[r * 1024 + k0 + j] * w4[j]; }
#pragma unroll
              for (int r = 0; r < 9; ++r) *(f32x4*)(red + ks * 432 + (r * 12 + cg) * 4) = acc[r]; }
          __syncthreads();
          if (tid < 432) { const int r = tid / 48, cc = tid % 48; float s = P.ada_b[li * 6144 + 48 * cb + cc];
              for (int ks = 0; ks < 32; ++ks) s += red[ks * 432 + tid];
              ((float*)(ws + WS_MOD))[(size_t)(li * 9 + r) * 6144 + 48 * cb + cc] = s; }
          __syncthreads(); } }
    if (blk == G - 1) { float* rp = (float*)(ws + WS_ROPE);
        for (int idx = tid; idx < 1024; idx += 512) { const int pos = idx >> 4, f = idx & 15; const double ang = (double)pos * pow(10000.0, -(double)f / 16.0); rp[idx] = (float)cos(ang); rp[1024 + idx] = (float)sin(ang); }
        for (int idx = tid; idx < 512; idx += 512) { const int pos = idx >> 3, f = idx & 7; const double ang = (double)pos * pow(10000.0, -(double)f / 8.0); rp[2048 + idx] = (float)cos(ang); rp[2560 + idx] = (float)sin(ang); } }
}

constexpr int NPHASE = 2 + 8 * DEPTH;
#ifndef PHMASK
#define PHMASK 0xFFFFFFFFu
#endif
#ifndef SUBMASK
#define SUBMASK 0xFFu
#endif
#define SUBEN(j) ((SUBMASK >> (j)) & 1u)
#define PHEN(k) ((PHMASK >> ((k) < 2 ? (k) : 2 + (((k) - 2) & 7))) & 1u)

#define IN(k) (PHEN(k) && lo <= (k) && (k) < hi)
#define SEAM(k) do { if (IN(k) && IN((k) + 1)) { KParamsPtr kq = kparams(); XcdBarrier bar; bar.bar = (unsigned*)(kq->ws + WS_BAR); bar.x = xb_xcc_id(); bar.st = (volatile LAS unsigned*)(ldsL + LDS_BARW); xcd_barrier(bar); } } while (0)
#define WSP(T, off) ((T*)(ws + (off)))
#ifndef REPMASK
#define REPMASK 0u
#endif
#ifndef SUBREP
#define SUBREP 0u
#endif
#ifndef REP_N
#define REP_N 1
#endif
#define NREP(j) ((((REPMASK) >> (j)) & 1u) ? (1 + REP_N) : 1)
#define NSUB(x) ((((SUBREP) >> (x)) & 1u) ? (1 + REP_N) : 1)
#define FORCEBAR() do { KParamsPtr kq = kparams(); XcdBarrier bar; bar.bar = (unsigned*)(kq->ws + WS_BAR); bar.x = xb_xcc_id(); bar.st = (volatile LAS unsigned*)(ldsL + LDS_BARW); xcd_barrier(bar); } while (0)
#define REPBEG(j) for (int rep_ = 0; rep_ < NREP(j); ++rep_) {
#define REPEND(j) if (rep_ + 1 < NREP(j)) FORCEBAR(); }
#define CNTP(r) (WSP(unsigned, WS_CNT) + (li * 4 + (r)) * 64)


template <int li>
DI void layer_phases(unsigned char* smem, LAS unsigned char* ldsL, const int lo, const int hi) {
        const int pb = 2 + 8 * li;
        REPBEG(2) if (IN(pb)) {
            for (int srep_ = 0; srep_ < NSUB(0); ++srep_) if (SUBEN(0)) { KParamsPtr kp = kparams(); unsigned char* ws = kp->ws;
              SchedProjTok S{(unsigned)(WS_WTOK + (size_t)li * SZ_WTOK), (int)gridDim.x, vcu(), li == DEPTH - 1};
              { LAS float* rl = (LAS float*)(ldsL + LDS_ROPE); const float* rg = WSP(const float, WS_ROPE);
                for (int idx = ld_tid(); idx < 65 * 48; idx += 512) { int tb, o; if (idx < 2 * 65 * 16) { tb = idx / (65 * 16); o = idx % (65 * 16); } else { const int j = idx - 2 * 65 * 16; tb = 2 + j / (65 * 8); o = j % (65 * 8); }
                    const int w = tb < 2 ? 16 : 8, pos = o / w, f = o % w; const bool cosine = (tb & 1) == 0;
                    rl[idx] = pos < 64 ? rg[(tb < 2 ? tb * 1024 : 2048 + (tb - 2) * 512) + pos * w + f] : (cosine ? 1.0f : 0.0f); }
                __syncthreads(); }
              EpiProjTok E{li, (LAS const float*)(ldsL + LDS_ROPE)};
              pg8::gemm_phase<EpiProjTok, SchedProjTok, false>(ldsL, ws, 2048u, 2048u, 16, S, E); }
            for (int srep_ = 0; srep_ < NSUB(1); ++srep_) if (SUBEN(1)) { KParamsPtr kp = kparams(); unsigned char* ws = kp->ws;
              SchedProjCh S{(unsigned)(WS_WCH + (size_t)li * SZ_WCH), (int)gridDim.x, (int)((vcu() + gridDim.x - 48) % gridDim.x), li == DEPTH - 1};
              EpiProjCh E{};
              pg8::gemm_phase<EpiProjCh, SchedProjCh, true>(ldsL, ws, 2048u, 2048u, 16, S, E); }
        }
        REPEND(2)
        SEAM(pb);
        REPBEG(3) if (IN(pb + 1)) {
            { KParamsPtr kp = kparams(); unsigned char* ws = kp->ws;
              fft_load_a(smem + FF1_A, WSP(const bf16_t, WS_M1), 128);
              for (int L = blockIdx.x; L < 512; L += gridDim.x) fft1_unit(smem, ws, L);
              asm volatile("s_waitcnt vmcnt(0)" ::: "memory"); __syncthreads();
              if (threadIdx.x == 0) { __builtin_amdgcn_fence(__ATOMIC_RELEASE, "agent"); (void)xb_add(CNTP(3), 1u); } }
            for (int srep_ = 0; srep_ < NSUB(2); ++srep_) if (SUBEN(2)) { KParamsPtr kp = kparams(); unsigned char* ws = kp->ws; const int G = gridDim.x, lane = ld_tid() & 63;
              const float lam_init = 0.8f - 0.6f * __expf(-0.3f * (float)li);
              float lam;
              { const float* dl = kp->d_lambda + li * 128; float a = 0.f, b = 0.f; if (lane < 32) { a = dl[lane] * dl[32 + lane]; b = dl[64 + lane] * dl[96 + lane]; }
                lam = __expf(wave_sum(a)) - __expf(wave_sum(b)) + lam_init; }
              bf16_t* QD = WSP(bf16_t, WS_QD); bf16_t* KD = WSP(bf16_t, WS_KD); bf16_t* VTD = WSP(bf16_t, WS_VTD); bf16_t* CAT = WSP(bf16_t, WS_CAT);
              for (int L = blockIdx.x; L < (li == DEPTH - 1 ? 512 : 512 + 32); L += G) {
                AttnArgs a; int b, hd, qrow;
                if (L < 512) { b = L >> 6; hd = (L >> 4) & 3; qrow = b * SEQ + (L & 15) * 256; a.t0 = 0; } else { const int j = L - 512; b = j >> 2; hd = j & 3; qrow = NLAT + b * CTX; a.t0 = 64; }
                a.t1 = 68; a.q = QD + (size_t)qrow * 256 + hd * 64; a.klat = KD + (size_t)(b * SEQ) * 256 + hd * 64; a.kctx = KD + (size_t)(NLAT + b * CTX) * 256 + hd * 64; a.kpitch = 256;
                a.vt = VTD + (size_t)((b * 4 + hd) * 64) * KEYS; a.out = CAT + (size_t)qrow * 1024 + 768 + hd * 64; a.lam = lam; a.oscale = 1.0f - lam_init; a.subg = kp->d_subg + li * 64; a.wl = -1; a.wli = li;
                attn_unit<true>(smem, a);
              } }
            { KParamsPtr kq = kparams(); unsigned* bar = (unsigned*)(kq->ws + WS_BAR); unsigned* flag = (unsigned*)(kq->ws + WS_CNT) + (li * 4 + 3) * 64;
              if (threadIdx.x == 0) { const unsigned G_ = gridDim.x; XB_SPIN(xb_ld(flag) < G_, bar); __builtin_amdgcn_fence(__ATOMIC_ACQUIRE, "agent"); asm volatile("s_waitcnt vmcnt(0)" ::: "memory"); }
              __syncthreads(); }
            { KParamsPtr kp = kparams(); unsigned char* ws = kp->ws;
              fft_load_a(smem + FF3_A, WSP(const bf16_t, WS_M3), 64);
              for (int L = blockIdx.x; L < 512; L += gridDim.x) fft3_unit(smem, ws, L); }
            for (int srep_ = 0; srep_ < NSUB(3); ++srep_) if (SUBEN(3)) { KParamsPtr kp = kparams(); unsigned char* ws = kp->ws; const int G = gridDim.x;
              bf16_t* QA = WSP(bf16_t, WS_QA); bf16_t* KA = WSP(bf16_t, WS_KA); bf16_t* VTA = WSP(bf16_t, WS_VTA); bf16_t* CAT = WSP(bf16_t, WS_CAT);
              for (int it = 0; ; ++it) {
                int L = (int)blockIdx.x + it * G;
                if (G == 256 && it == 2) { const int j = (int)blockIdx.x - 32; if (j < 0 || j >= 32) break; L = 512 + j; }
                if (L >= (li == DEPTH - 1 ? 512 : 512 + 32)) break;
                AttnArgs a; int b, hd, qrow;
                if (L < 512) { b = L >> 6; hd = (L >> 4) & 3; qrow = b * SEQ + (L & 15) * 256; a.t0 = 0; } else { const int j = L - 512; b = j >> 2; hd = j & 3; qrow = NLAT + b * CTX; a.t0 = 64; }
                a.t1 = 68; a.q = QA + (size_t)qrow * 256 + hd * 64; a.klat = KA + (size_t)(b * SEQ) * 128 + (hd >> 1) * 64; a.kctx = KA + (size_t)(NLAT + b * CTX) * 128 + (hd >> 1) * 64; a.kpitch = 128;
                a.vt = VTA + (size_t)((b * 2 + (hd >> 1)) * 64) * KEYS; a.out = CAT + (size_t)qrow * 1024 + hd * 64; a.lam = 0.f; a.oscale = 1.f; a.subg = nullptr; a.wl = L < 512 ? L : -1; a.wli = li;
                attn_unit_a8(smem, a);
              } }
            for (int srep_ = 0; srep_ < NSUB(5); ++srep_) if (SUBEN(5) && li < DEPTH - 1) { KParamsPtr kp = kparams(); unsigned char* ws = kp->ws;
              SchedFourCtx S{(int)gridDim.x, (int)((blockIdx.x + gridDim.x - 96 % gridDim.x) % gridDim.x)}; EpiFourier E{};
              pg8::gemm_phase<EpiFourier, SchedFourCtx, true>(ldsL, ws, 1024u, 1024u, 8, S, E); }
            for (int srep_ = 0; srep_ < NSUB(6); ++srep_) if (SUBEN(6)) { KParamsPtr kp = kparams(); unsigned char* ws = kp->ws; const int G = gridDim.x;
              for (int it = 0; ; ++it) {
                int L = (int)blockIdx.x + it * G;
                if (G == 256 && it == 2) { const int j = (int)blockIdx.x - 64; if (j < 0 || j >= 32) break; L = 512 + j; }
                if (L >= (li == DEPTH - 1 ? 512 : 512 + 32)) break;
                int seqrow, Ls, t0;
                if (L < 512) { seqrow = (L >> 6) * SEQ; Ls = SEQ; t0 = (L & 63) * 64; } else { const int j = L - 512; seqrow = NLAT + (j >> 2) * CTX; Ls = CTX; t0 = (j & 3) * 64; }
                conv_unit(smem, seqrow, Ls, t0, WSP(const bf16_t, WS_BU), WSP(const bf16_t, WS_BG), kp->conv_w + li * 31 * 256, kp->conv_b + li * 256, kp->conv_lg + li * 256, kp->conv_lb + li * 256, WSP(bf16_t, WS_CAT));
              } }
        }
        REPEND(3)
        SEAM(pb + 1);
        REPBEG(4) if (IN(pb + 2)) { KParamsPtr kp = kparams(); unsigned char* ws = kp->ws;
            SchedOut S{(unsigned)(WS_WOUT + (size_t)li * SZ_WOUT), (int)gridDim.x, vcu(), li == DEPTH - 1 ? 128 : NTILE_TOK};
            EpiOut E{li};
            pg8::gemm_phase<EpiOut, SchedOut, false>(ldsL, ws, 2048u, 2048u, 16, S, E);
        }
        REPEND(4)
        SEAM(pb + 2);
        REPBEG(5) if (IN(pb + 3)) { const Params P = *kparams(); unsigned char* ws = P.ws;
            phase_router(smem, P, li, WSP(const bf16_t, WS_X1), WSP(unsigned char, WS_H8), WSP(const float, WS_MOD) + (size_t)li * 9 * 6144, CNTP(rep_), WSP(int, WS_TOKE), WSP(int, WS_TOKP), WSP(float, WS_TOKG), WSP(int, WS_TOKL), gridDim.x, li == DEPTH - 1 ? NLAT : NTOK, li == DEPTH - 1 ? 128 : RT_CH); }
        REPEND(5)
        SEAM(pb + 3);
        REPBEG(7) if (IN(pb + 5)) { KParamsPtr kp = kparams(); unsigned char* ws = kp->ws; LAS int* tab = (LAS int*)(ldsL + LDS_TAB);
            moe_tables(tab, CNTP(NREP(5) - 1));
            SchedMoe<8, true> S{0u, (unsigned)(WS_WGU + (size_t)li * SZ_WGU), 2048u * 1024u, tab, (int)gridDim.x, (int)blockIdx.x};
            EpiMoe1 E{li};
            pg8::gemm_phase<EpiMoe1, SchedMoe<8, true>, false, true, true>(ldsL, ws, 1024u, 1024u, 8, S, E); }
        REPEND(7)
        SEAM(pb + 5);
        REPBEG(8) if (IN(pb + 6)) { KParamsPtr kp = kparams(); unsigned char* ws = kp->ws; LAS int* tab = (LAS int*)(ldsL + LDS_TAB);
            moe_tables(tab, CNTP(NREP(5) - 1));
            SchedMoe<4> S{(unsigned)WS_ACT, (unsigned)(WS_WDN + (size_t)li * SZ_WDN), 1024u * 1024u, tab, (int)gridDim.x, (int)blockIdx.x};
            EpiMoe2 E{li};
            pg8::gemm_phase<EpiMoe2, SchedMoe<4>, false, true>(ldsL, ws, 1024u, 1024u, 8, S, E); }
        REPEND(8)
        SEAM(pb + 6);
        REPBEG(9) if (IN(pb + 7)) { const Params P = *kparams(); unsigned char* ws = P.ws; const float* MOD = WSP(const float, WS_MOD); LAS int* tab = (LAS int*)(ldsL + LDS_TAB);
            moe_tables(tab, CNTP(NREP(5) - 1));
            phase_combine(P, li, WSP(const bf16_t, WS_X1), WSP(bf16_t, WS_X2), WSP(const unsigned char, WS_XP) + (size_t)MAXMT * 256 * 1024, tab, WSP(const int, WS_TOKE), WSP(const int, WS_TOKP), WSP(const float, WS_TOKG), MOD + (size_t)li * 9 * 6144, MOD + (size_t)(li + 1 < DEPTH ? li + 1 : li) * 9 * 6144, WSP(bf16_t, WS_H), gridDim.x); }
        REPEND(9)
        SEAM(pb + 7);
}

__global__ void __launch_bounds__(512, 2) mega(Params Pdummy) {
    extern __shared__ __attribute__((aligned(16))) unsigned char smem[];
    LAS unsigned char* ldsL = (LAS unsigned char*)smem;
    if (threadIdx.x < 4) ((LAS unsigned*)(ldsL + LDS_BARW))[threadIdx.x] = 0u;
    __syncthreads();
    { KParamsPtr kp = kparams(); (void)xcd_barrier_post((unsigned*)(kp->ws + WS_BAR), (volatile LAS unsigned*)(ldsL + LDS_BARW)); }
    int lo, hi; { KParamsPtr kp = kparams(); lo = kp->ph_lo; hi = kp->ph_hi; }
    REPBEG(0) if (IN(0)) { const Params P = *kparams(); phase_prep(smem, P, gridDim.x); } REPEND(0)
    SEAM(0);
    REPBEG(1) if (IN(1)) { const Params P = *kparams(); unsigned char* ws = P.ws; phase_norm1(P, WSP(bf16_t, WS_H), WSP(const float, WS_MOD), gridDim.x); } REPEND(1)
    SEAM(1);
    layer_phases<0>(smem, ldsL, lo, hi);
    layer_phases<1>(smem, ldsL, lo, hi);
    static_assert(DEPTH == 2, "two layers are written out");
#undef IN
#undef SEAM
}

#ifndef MK_MULTI
#define MK_MULTI 0
#endif
extern "C" void kernel_launch(void* const* d_in, const int* in_sizes, int n_in, void* d_out, int out_size, void* d_ws, size_t ws_size, hipStream_t stream) {
    static int grid = 0;
    if (grid == 0) {
        if (n_in != 26 || ws_size < WS_END) { fprintf(stderr, "kernel_launch: need 26 inputs and %zu bytes of workspace (got %d, %zu)\n", (size_t)WS_END, n_in, ws_size); grid = -1; return; }
        int dev = 0, cus = 0, per_cu = 0;
        if (hipGetDevice(&dev) != hipSuccess || hipDeviceGetAttribute(&cus, hipDeviceAttributeMultiprocessorCount, dev) != hipSuccess) { grid = -1; return; }
        if (hipFuncSetAttribute((const void*)mega, hipFuncAttributeMaxDynamicSharedMemorySize, LDS_BYTES) != hipSuccess) { fprintf(stderr, "kernel_launch: hipFuncSetAttribute failed\n"); grid = -1; return; }
        if (hipOccupancyMaxActiveBlocksPerMultiprocessor(&per_cu, (const void*)mega, 512, LDS_BYTES) != hipSuccess || per_cu < 1) fprintf(stderr, "kernel_launch: occupancy query says %d\n", per_cu);
        (void)hipGetLastError();
        grid = cus;
    }
    if (grid < 0) return;
    (void)hipMemsetAsync(d_ws, 0, WS_ZERO_BYTES, stream);
    Params p{};
    const float** pf = (const float**)&p;
    for (int i = 0; i < 26; ++i) pf[i] = (const float*)d_in[i];
    p.out = (float*)d_out; p.ws = (unsigned char*)d_ws;
#if MK_MULTI
    for (int k = 0; k < NPHASE; ++k) { p.ph_lo = k; p.ph_hi = k + 1; hipLaunchKernelGGL(mega, dim3(grid), dim3(512), LDS_BYTES, stream, p); }
#else
    p.ph_lo = 0; p.ph_hi = NPHASE;
    hipLaunchKernelGGL(mega, dim3(grid), dim3(512), LDS_BYTES, stream, p);
#ifdef EXTRA_PHASE
    p.ph_lo = EXTRA_PHASE; p.ph_hi = EXTRA_PHASE + 1;
    hipLaunchKernelGGL(mega, dim3(grid), dim3(512), LDS_BYTES, stream, p);
#endif
#endif
}
```

```cpp
#include <hip/hip_runtime.h>
#include <stdint.h>
#include <stdio.h>

#define DI __device__ __forceinline__
#define LAS __attribute__((address_space(3)))
typedef unsigned short bf16_t;
typedef short bf16x8 __attribute__((ext_vector_type(8)));
typedef short s16x4 __attribute__((ext_vector_type(4)));
typedef float f32x2 __attribute__((ext_vector_type(2)));
typedef float f32x4 __attribute__((ext_vector_type(4)));
typedef float f32x16 __attribute__((ext_vector_type(16)));
typedef unsigned u32x2 __attribute__((ext_vector_type(2)));
typedef unsigned u32x4 __attribute__((ext_vector_type(4)));
typedef __bf16 bf16x2_t __attribute__((ext_vector_type(2)));
typedef int v4i __attribute__((ext_vector_type(4)));
typedef int v8i __attribute__((ext_vector_type(8)));

constexpr int DM = 1024, NB = 8, SEQ = 4096, CTX = 256, NLAT = NB * SEQ, NCTX = NB * CTX, NTOK = NLAT + NCTX, DEPTH = 2;
constexpr int NE = 32, TOPK = 4, KEYS = SEQ + CTX;
constexpr int NTILE_TOK = NTOK / 256;
constexpr int MAXMT = 576;
constexpr float EPS = 1e-6f;
constexpr float LOG2E = 1.4426950408889634f;
constexpr float W8_SCALE = 64.0f, W8_INV = 1.0f / 64.0f;

constexpr size_t al256(size_t x) { return (x + 255) & ~(size_t)255; }
constexpr size_t WS_BAR = 0;
constexpr size_t WS_CNT = 16384;
constexpr size_t WS_ZERO_BYTES = 20480;
constexpr size_t WS_MOD = WS_ZERO_BYTES;
constexpr size_t WS_ROPE = al256(WS_MOD + (size_t)DEPTH * 9 * 6144 * 4);
constexpr size_t WS_TOKE = al256(WS_ROPE + 3072 * 4);
constexpr size_t WS_TOKP = al256(WS_TOKE + (size_t)NTOK * 4 * 4);
constexpr size_t WS_TOKG = al256(WS_TOKP + (size_t)NTOK * 4 * 4);
constexpr size_t WS_TOKS = al256(WS_TOKG + (size_t)NTOK * 4 * 4);
constexpr size_t WS_WTOK = al256(WS_TOKS + (size_t)NTOK * 4 * 4);
constexpr size_t SZ_WTOK = (size_t)1536 * 1024 * 2;
constexpr size_t WS_WCH = WS_WTOK + DEPTH * SZ_WTOK;
constexpr size_t SZ_WCH = (size_t)1024 * 1024 * 2;
constexpr size_t WS_WOUT = WS_WCH + DEPTH * SZ_WCH;
constexpr size_t SZ_WOUT = (size_t)1024 * 1024 * 2;
constexpr size_t WS_WGU = WS_WOUT + DEPTH * SZ_WOUT;
constexpr size_t SZ_WGU = (size_t)NE * 2048 * 1024 * 2;
constexpr size_t WS_WDN = WS_WGU + DEPTH * SZ_WGU;
constexpr size_t SZ_WDN = (size_t)NE * 1024 * 1024 * 2;
constexpr size_t WS_TL = WS_WDN + DEPTH * SZ_WDN;
constexpr size_t WS_Y2 = WS_TL;
constexpr size_t WS_M1 = WS_TL + (size_t)NB * 64 * 256 * 128 * 2;
constexpr size_t WS_M3 = WS_M1 + 128 * 128 * 2;
constexpr size_t WS_TW = WS_M3 + 64 * 128 * 2;
constexpr size_t WS_TC = WS_TL + (size_t)4096 * 8192 * 2;
constexpr size_t WS_H = WS_TC + (size_t)256 * 512 * 2;
constexpr size_t WS_QA = WS_H + (size_t)NTOK * 1024 * 2;
constexpr size_t WS_KA = WS_QA + (size_t)NTOK * 256 * 2;
constexpr size_t WS_BU = WS_KA + (size_t)NTOK * 128 * 2;
constexpr size_t WS_BG = WS_BU + (size_t)NTOK * 256 * 2;
constexpr size_t WS_QD = WS_BG + (size_t)NTOK * 256 * 2;
constexpr size_t WS_KD = WS_QD + (size_t)NTOK * 256 * 2;
constexpr size_t WS_VTA = WS_KD + (size_t)NTOK * 256 * 2;
constexpr size_t WS_VTD = WS_VTA + (size_t)NB * 2 * 64 * KEYS * 2;
constexpr size_t WS_FT = WS_VTD + (size_t)NB * 4 * 64 * KEYS * 2;
constexpr size_t WS_FTC = WS_FT + (size_t)NB * 256 * 8192 * 2;
constexpr size_t WS_CAT = WS_FTC + (size_t)NB * 256 * 512 * 2;
constexpr size_t WS_X1 = WS_CAT + (size_t)NTOK * 1024 * 2;
constexpr size_t WS_X2 = WS_X1 + (size_t)NTOK * 1024 * 2;
constexpr size_t WS_XP = WS_X2 + (size_t)NTOK * 1024 * 2;
constexpr size_t WS_ACT = WS_XP + (size_t)MAXMT * 256 * 1024 * 2;
constexpr size_t WS_H8 = WS_ACT + (size_t)MAXMT * 256 * 1024 * 2;
constexpr size_t WS_TOKL = WS_H8 + (size_t)NTOK * 1024;
constexpr size_t WS_END = WS_TOKL + ((size_t)NE * NTOK + 1024) * 4;

constexpr int LDS_GEMM = 131072;
constexpr int LDS_TAB = LDS_GEMM;
constexpr int LDS_TOKT = LDS_TAB + 3072;
constexpr int LDS_BARW = LDS_GEMM + 4096;
constexpr int LDS_ROPE = LDS_BARW + 16;
constexpr int LDS_BYTES = LDS_ROPE + 65 * 48 * 4;

struct Params {
    const float* x; const float* c; const float* ctx; const float* c_ctx;
    const float* norm1_g; const float* norm2_g; const float* ada_w; const float* ada_b; const float* w_in;
    const float* a_qg; const float* a_kg; const float* conv_w; const float* conv_b; const float* conv_lg; const float* conv_lb;
    const float* d_qg; const float* d_kg; const float* d_lambda; const float* d_subg; const float* w_out;
    const float* router_w; const float* router_b; const float* w_gu; const float* b_gu; const float* w_dn; const float* b_dn;
    float* out; unsigned char* ws;
    int ph_lo, ph_hi;
};

#if defined(__HIP_DEVICE_COMPILE__)
typedef const Params __attribute__((address_space(4))) * KParamsPtr;
#else
typedef const Params* KParamsPtr;
#endif
DI KParamsPtr kparams() { KParamsPtr p = (KParamsPtr)__builtin_amdgcn_kernarg_segment_ptr(); asm volatile("" : "+s"(p)); return p; }
DI int ld_tid() { int t = threadIdx.x; asm volatile("" : "+v"(t)); return t; }
DI int vcu() { const int G = gridDim.x, c = blockIdx.x; return (G & 7) == 0 ? (c & 7) * (G >> 3) + (c >> 3) : c; }

DI unsigned pk2(float lo, float hi) { f32x2 v = {lo, hi}; bf16x2_t b = __builtin_convertvector(v, bf16x2_t); return __builtin_bit_cast(unsigned, b); }
DI unsigned pk4_fp8(float a, float b, float c, float d) { int r = 0; r = __builtin_amdgcn_cvt_pk_fp8_f32(a, b, r, false); r = __builtin_amdgcn_cvt_pk_fp8_f32(c, d, r, true); return (unsigned)r; }
DI float clamp448(float x) { return __builtin_amdgcn_fmed3f(x, -448.0f, 448.0f); }
DI float bf2f(bf16_t b) { return __uint_as_float(((unsigned)b) << 16); }
DI float bflo(unsigned u) { return __uint_as_float(u << 16); }
DI float bfhi(unsigned u) { return __uint_as_float(u & 0xffff0000u); }
DI float wave_sum(float v) {
#pragma unroll
    for (int o = 32; o >= 1; o >>= 1) v += __shfl_xor(v, o);
    return v;
}
DI float sum_x16_x32(float v) {
    { const auto r = __builtin_amdgcn_permlane16_swap(__float_as_uint(v), __float_as_uint(v), false, false); v = __uint_as_float(r[0]) + __uint_as_float(r[1]); }
    { const auto r = __builtin_amdgcn_permlane32_swap(__float_as_uint(v), __float_as_uint(v), false, false); v = __uint_as_float(r[0]) + __uint_as_float(r[1]); }
    return v;
}
DI float sigmoidf_(float x) { return 1.0f / (1.0f + __expf(-x)); }
DI int perm32(int rho) { const int n = rho >> 4, i = rho & 15; return 8 * (i >> 2) + 4 * n + (i & 3); }

#define XB_TMO      128
#define XB_XCNT(j)  (256  + 64 * (j))
#define XB_XSUB(j)  (1280 + 64 * (j))
#define XB_XGEN(j)  (2304 + 64 * (j))
#define XB_TOP      3328
#define XB_TOPGEN   3392
#define XCD_BAR_WORDS 3456
#define XB_SPIN_CAP (1u << 18)
DI unsigned xb_ld(unsigned* p)              { return __hip_atomic_load(p, __ATOMIC_RELAXED, __HIP_MEMORY_SCOPE_AGENT); }
DI unsigned xb_add(unsigned* p, unsigned v) { return __hip_atomic_fetch_add(p, v, __ATOMIC_RELAXED, __HIP_MEMORY_SCOPE_AGENT); }
DI unsigned xb_xcc_id() { return (unsigned)__builtin_amdgcn_s_getreg((3 << 11) | 20) & 0xFu; }
#define XB_SPIN(cond, bar) do { unsigned _sp = 0; while (cond) { __builtin_amdgcn_s_sleep(1); \
    if ((++_sp & 255u) == 0u) { if (xb_ld(&(bar)[XB_TMO])) break; if (_sp > XB_SPIN_CAP) { atomicAdd(&(bar)[XB_TMO], 1u); break; } } } } while (0)
struct XcdBarrier { unsigned* bar; unsigned x; volatile LAS unsigned* st; };
DI XcdBarrier xcd_barrier_post(unsigned* bar, volatile LAS unsigned* st) {
    XcdBarrier b; b.bar = bar; b.x = xb_xcc_id(); b.st = st;
    if (threadIdx.x == 0) (void)xb_add(&bar[XB_XCNT(b.x)], 1u);
    return b;
}
DI void xcd_barrier_complete(unsigned* bar, unsigned x, unsigned& nloc, unsigned& nx) {
    const unsigned G = gridDim.x * gridDim.y * gridDim.z;
    unsigned sum, cnt, mine, sp = 0u;
    for (;;) {
        sum = 0u; cnt = 0u; mine = 0u;
#pragma unroll
        for (unsigned j = 0; j < 16; ++j) { const unsigned c = xb_ld(&bar[XB_XCNT(j)]); sum += c; cnt += (c > 0u) ? 1u : 0u; mine = (j == x) ? c : mine; }
        if (sum == G) break;
        __builtin_amdgcn_s_sleep(1);
        if ((++sp & 255u) == 0u) { if (xb_ld(&bar[XB_TMO])) break; if (sp > XB_SPIN_CAP) { atomicAdd(&bar[XB_TMO], 1u); break; } }
    }
    nloc = mine > 0u ? mine : 1u; nx = cnt > 0u ? cnt : 1u;
}
DI void xcd_barrier(const XcdBarrier& b) {
    asm volatile("s_waitcnt vmcnt(0)" ::: "memory");
    __syncthreads();
    if (threadIdx.x == 0) {
        unsigned* bar = b.bar;
        __builtin_amdgcn_s_waitcnt(0);
        unsigned nloc = b.st[0], nx = b.st[1];
        if (nloc == 0u) { xcd_barrier_complete(bar, b.x, nloc, nx); b.st[0] = nloc; b.st[1] = nx; }
        const unsigned old = xb_add(&bar[XB_XSUB(b.x)], 1u);
        const unsigned gen = old / nloc;
        if (old + 1u == (gen + 1u) * nloc) {
            __builtin_amdgcn_fence(__ATOMIC_RELEASE, "agent");
            asm volatile("s_waitcnt vmcnt(0)" ::: "memory");
            const unsigned og = xb_add(&bar[XB_TOP], 1u);
            const unsigned tg = og / nx;
            if (og + 1u == (tg + 1u) * nx) xb_add(&bar[XB_TOPGEN], 1u);
            else XB_SPIN(xb_ld(&bar[XB_TOPGEN]) == tg, bar);
            __builtin_amdgcn_fence(__ATOMIC_ACQUIRE, "agent");
            xb_add(&bar[XB_XGEN(b.x)], 1u);
            asm volatile("s_waitcnt vmcnt(0)" ::: "memory");
        } else {
            XB_SPIN(xb_ld(&bar[XB_XGEN(b.x)]) == gen, bar);
            __builtin_amdgcn_fence(__ATOMIC_ACQUIRE, "agent");
            asm volatile("s_waitcnt vmcnt(0)" ::: "memory");
        }
    }
    __syncthreads();
}

namespace pg8 {
constexpr int BK = 64, HALF = 128, HTB = HALF * BK * 2, STAGE_BYTES = 8 * HTB;
DI int lds_byte(int r, int c) { const int st = (r >> 4) * 2 + (c >> 5), rr = r & 15, cc = c & 31, ob = rr * 64 + cc * 2; return st * 1024 + (ob ^ (((ob >> 9) & 1) << 5)); }
DI void stage_rc(int b, int& R, int& C) { const int st = b / 1024, sb = b % 1024, swz = sb ^ (((sb >> 9) & 1) << 5); R = (st >> 1) * 16 + swz / 64; C = (st & 1) * 32 + (swz % 64) / 2; }
struct GUnit { unsigned A, B; int pm, pn, e; };

template <class Epi, class Sched, bool PERM, bool FP8 = false, bool GATHER = false>
DI void gemm_phase(LAS unsigned char* lds, const unsigned char* wsb, const unsigned lda, const unsigned ldb, const int nt, const Sched& S, const Epi& E) {
    int tid = threadIdx.x; asm volatile("" : "+v"(tid));
    const int wid = __builtin_amdgcn_readfirstlane(tid >> 6), lane = tid & 63, wr = wid >> 2, wc = wid & 3, fr = lane & 15, fq = lane >> 4;
    unsigned voffA[2], voffB[2];
#pragma unroll
    for (int i = 0; i < 2; ++i) { int R, C; stage_rc(tid * 16 + i * 8192, R, C); const int Rb = PERM ? ((R & ~31) + perm32(R & 31)) : R;
        voffA[i] = (unsigned)R * lda + (unsigned)C * 2u; voffB[i] = (unsigned)Rb * ldb + (unsigned)C * 2u; }
    const unsigned kstep = (unsigned)(BK * 2);
    const unsigned hstepA = (unsigned)HALF * lda, hstepB = (unsigned)HALF * ldb;
    unsigned offC[2][2];
#pragma unroll
    for (int i = 0; i < 2; ++i) offC[0][i] = offC[1][i] = 0u;
    const int* tokl = (const int*)(wsb + WS_TOKL);
    LAS int* tokt = (LAS int*)(lds + LDS_TOKT);
    const unsigned ldsw = (unsigned)wid * 1024u;
    const LAS unsigned char* pa = lds + lds_byte(wr * 64 + fr, fq * 8); const LAS unsigned char* pb = lds + 4 * HTB + lds_byte(wc * 32 + fr, fq * 8);
    asm volatile("" : "+v"(pa), "+v"(pb));
#define PG8_SA(b, h) (((b) * 2 + (h)) * HTB)
#define PG8_SB(b, h) ((4 + (b) * 2 + (h)) * HTB)
#define PG8_STAGE(bufoff, gbase, voff) do { _Pragma("unroll") for (int _i = 0; _i < 2; ++_i) \
        __builtin_amdgcn_global_load_lds((const unsigned*)(wsb + (size_t)(gbase) + (voff)[_i]), (LAS unsigned*)(lds + (bufoff) + ldsw + _i * 8192), 16, 0, 0); } while (0)
#define PG8_STAGEA(bufoff, kt, h, nx) do { if constexpr (GATHER) { _Pragma("unroll") for (int _i = 0; _i < 2; ++_i) \
        __builtin_amdgcn_global_load_lds((const unsigned*)(wsb + WS_H8 + (size_t)((unsigned)(kt) * kstep) + offC[h][_i]), (LAS unsigned*)(lds + (bufoff) + ldsw + _i * 8192), 16, 0, 0); } \
        else PG8_STAGE(bufoff, ((nx) ? nA : cA) + (unsigned)(kt) * kstep + (unsigned)(h) * hstepA, voffA); } while (0)
#define PG8_LD8(p, off) __builtin_shufflevector(*(const LAS v4i*)((p) + (off)), *(const LAS v4i*)((p) + (off) + 1024), 0, 1, 2, 3, 4, 5, 6, 7)
#define PG8_LDA(dst, b, h) do { _Pragma("unroll") for (int m = 0; m < 4; ++m) { if constexpr (FP8) dst##8[m] = PG8_LD8(pa, PG8_SA(b, h) + m * 2048); \
        else { _Pragma("unroll") for (int k = 0; k < 2; ++k) dst[m][k] = *(const LAS bf16x8*)(pa + PG8_SA(b, h) + m * 2048 + k * 1024); } } } while (0)
#define PG8_LDB(dst, b, h) do { _Pragma("unroll") for (int n = 0; n < 2; ++n) { if constexpr (FP8) dst##8[n] = PG8_LD8(pb, PG8_SA(b, h) + n * 2048); \
        else { _Pragma("unroll") for (int k = 0; k < 2; ++k) dst[n][k] = *(const LAS bf16x8*)(pb + PG8_SA(b, h) + n * 2048 + k * 1024); } } } while (0)
#define PG8_CAT(x) __builtin_shufflevector(__builtin_bit_cast(v4i, (x)[0]), __builtin_bit_cast(v4i, (x)[1]), 0, 1, 2, 3, 4, 5, 6, 7)
#define PG8_MMA(ai, bj, At, Bt) do { __builtin_amdgcn_s_setprio(1); _Pragma("unroll") for (int m = 0; m < 4; ++m) _Pragma("unroll") for (int n = 0; n < 2; ++n) { \
        if constexpr (FP8) acc[ai][bj][m][n] = __builtin_amdgcn_mfma_scale_f32_16x16x128_f8f6f4(Bt##8[n], At##8[m], acc[ai][bj][m][n], 0, 0, 0, 0, 0, 0); \
        else { _Pragma("unroll") for (int k = 0; k < 2; ++k) acc[ai][bj][m][n] = __builtin_amdgcn_mfma_f32_16x16x32_bf16(Bt[n][k], At[m][k], acc[ai][bj][m][n], 0, 0, 0); } } \
        __builtin_amdgcn_s_setprio(0); } while (0)
#define PG8_WAIT_V(n) asm volatile("s_waitcnt vmcnt(" #n ")" ::: "memory")
#define PG8_WAIT_L(n) asm volatile("s_waitcnt lgkmcnt(" #n ")" ::: "memory")
#define PG8_BAR __builtin_amdgcn_s_barrier()
#define PG8_SCHED __builtin_amdgcn_sched_barrier(0)
    GUnit cur, nxt; int ui = 0;
    if (!S.next(0, cur)) return;
    f32x4 acc[2][2][4][2];
#pragma unroll
    for (int a = 0; a < 2; ++a)
#pragma unroll
        for (int b = 0; b < 2; ++b)
#pragma unroll
            for (int m = 0; m < 4; ++m)
#pragma unroll
                for (int n = 0; n < 2; ++n) acc[a][b][m][n] = (f32x4){0.f, 0.f, 0.f, 0.f};
    bf16x8 At[4][2], B0[2][2], B1[2][2]; v8i At8[4], B08[2], B18[2];
    unsigned cA = cur.A, cB = cur.B, nA = cur.A, nB = cur.B;
    if constexpr (GATHER) {
#pragma unroll
        for (int i = 0; i < 2; ++i) { int R, C; stage_rc(tid * 16 + i * 8192, R, C);
#pragma unroll
            for (int h = 0; h < 2; ++h) { const unsigned tk = (unsigned)tokl[cur.A + h * HALF + R]; offC[h][i] = (tk < (unsigned)NTOK ? tk : (unsigned)(NTOK - 1)) * lda + (unsigned)C * 2u; } }
        asm volatile("" : "+v"(offC[0][0]), "+v"(offC[0][1]), "+v"(offC[1][0]), "+v"(offC[1][1]));
    }
    PG8_STAGE(PG8_SB(0, 0), cB, voffB); PG8_STAGE(PG8_SB(0, 1), cB + hstepB, voffB); PG8_STAGEA(PG8_SA(0, 0), 0, 0, false); PG8_STAGEA(PG8_SA(0, 1), 0, 1, false);
    if (wr == 1) PG8_BAR;
    PG8_WAIT_V(2); PG8_BAR;
    PG8_STAGE(PG8_SB(1, 0), cB + kstep, voffB); PG8_STAGEA(PG8_SA(1, 0), 1, 0, false); PG8_STAGE(PG8_SB(1, 1), cB + hstepB + kstep, voffB);
    PG8_WAIT_V(6); PG8_BAR;
    for (;;) {
        const bool has_next = S.next(ui + 1, nxt);
        nA = has_next ? nxt.A : cA; nB = has_next ? nxt.B : cB;
        if constexpr (GATHER) {
            if (wid < 4) __builtin_amdgcn_global_load_lds((const unsigned*)(tokl + nA + tid), (LAS unsigned*)(tokt + wid * 64), 4, 0, 0);
        }
#pragma nounroll
        for (int t = 0; t < nt; t += 2) {
            const bool last = (t == nt - 2);
            const unsigned b2 = last ? nB : cB + (unsigned)(t + 2) * kstep, b3 = b2 + kstep;
            const int k2 = last ? 0 : t + 2, k3 = k2 + 1;
            PG8_LDB(B0, 0, 0); PG8_LDB(B1, 0, 1); PG8_SCHED; PG8_LDA(At, 0, 0); PG8_STAGEA(PG8_SA(1, 1), t + 1, 1, false);
            if constexpr (GATHER) { if (last) {
                int tz = tid; asm volatile("" : "+v"(tz));
#pragma unroll
                for (int i = 0; i < 2; ++i) { int R, C; stage_rc(tz * 16 + i * 8192, R, C);
#pragma unroll
                    for (int h = 0; h < 2; ++h) { const unsigned tk = (unsigned)tokt[h * HALF + R]; offC[h][i] = (tk < (unsigned)NTOK ? tk : (unsigned)(NTOK - 1)) * lda + (unsigned)C * 2u; } } } }
            PG8_WAIT_V(8); PG8_WAIT_L(0); PG8_BAR; PG8_MMA(0, 0, At, B0); PG8_MMA(0, 1, At, B1); PG8_BAR; PG8_SCHED;
            PG8_LDA(At, 0, 1); PG8_STAGE(PG8_SB(0, 0), b2, voffB); PG8_STAGE(PG8_SB(0, 1), b2 + hstepB, voffB); PG8_STAGEA(PG8_SA(0, 0), k2, 0, last);
            PG8_WAIT_V(8); PG8_WAIT_L(0); PG8_BAR; PG8_MMA(1, 0, At, B0); PG8_MMA(1, 1, At, B1); PG8_BAR; PG8_SCHED;
            PG8_LDB(B0, 1, 0); PG8_LDB(B1, 1, 1); PG8_SCHED; PG8_LDA(At, 1, 0); PG8_STAGEA(PG8_SA(0, 1), k2, 1, last);
            PG8_WAIT_V(8); PG8_WAIT_L(0); PG8_BAR; PG8_MMA(0, 0, At, B0); PG8_MMA(0, 1, At, B1); PG8_BAR; PG8_SCHED;
            PG8_LDA(At, 1, 1); PG8_STAGE(PG8_SB(1, 0), b3, voffB); PG8_STAGE(PG8_SB(1, 1), b3 + hstepB, voffB); PG8_STAGEA(PG8_SA(1, 0), k3, 0, last);
            PG8_WAIT_V(8); PG8_WAIT_L(0); PG8_BAR; PG8_MMA(1, 0, At, B0); PG8_MMA(1, 1, At, B1); PG8_BAR; PG8_SCHED;
        }

        if (wr == 0) PG8_BAR;
        E(acc, cur, wsb, wr, wc, fr, fq);
        if (!has_next) break;
#pragma unroll
        for (int a = 0; a < 2; ++a)
#pragma unroll
            for (int b = 0; b < 2; ++b)
#pragma unroll
                for (int m = 0; m < 4; ++m)
#pragma unroll
                    for (int n = 0; n < 2; ++n) acc[a][b][m][n] = (f32x4){0.f, 0.f, 0.f, 0.f};
        cur = nxt; cA = nA; cB = nB; ++ui;
        if (wr == 1) PG8_BAR;
    }
    PG8_WAIT_V(0);
    PG8_BAR;
#undef PG8_SA
#undef PG8_SB
#undef PG8_STAGE
#undef PG8_STAGEA
#undef PG8_LDA
#undef PG8_LD8
#undef PG8_LDB
#undef PG8_MMA
#undef PG8_CAT
#undef PG8_WAIT_V
#undef PG8_WAIT_L
#undef PG8_BAR
#undef PG8_SCHED
}
}
using pg8::GUnit;
typedef f32x4 AccT[2][2][4][2];

constexpr float C2A = LOG2E * 0.125f;
constexpr float C2D = LOG2E * 0.17677669529663687f;

DI void store8(bf16_t* p, f32x4 a) { u32x2 w; w.x = pk2(a[0], a[1]); w.y = pk2(a[2], a[3]); *(u32x2*)p = w; }
DI void store16(bf16_t* p, f32x4 a, f32x4 b) { u32x4 w; w.x = pk2(a[0], a[1]); w.y = pk2(a[2], a[3]); w.z = pk2(b[0], b[1]); w.w = pk2(b[2], b[3]); *(u32x4*)p = w; }
#define EPI_ARGS const AccT& acc, const GUnit& u, const unsigned char* wsb, int wr, int wc, int fr, int fq
#define EPI_OPAQUE() asm volatile("" : "+v"(fr), "+v"(fq))
#define WSB(T, off) ((T*)(const_cast<unsigned char*>(wsb) + (off)))

struct EpiProjTok {
    int li; LAS const float* rope;
    DI void head64(const AccT& acc, int rbase, int wc, int fq, bf16_t* dst, int pitch, const float* gain, float scale) const {
        LAS const float* cs16 = rope; LAS const float* sn16 = rope + 65 * 16;
        f32x4 g[2][2];
#pragma unroll
        for (int bj = 0; bj < 2; ++bj)
#pragma unroll
            for (int n = 0; n < 2; ++n) g[bj][n] = *(const f32x4*)(gain + 32 * bj + 16 * n + 4 * fq);
#pragma unroll
        for (int ai = 0; ai < 2; ++ai)
#pragma unroll
            for (int m = 0; m < 4; ++m) {
                const int row = rbase + 128 * ai + 16 * m;
                float ss = 0.f;
#pragma unroll
                for (int bj = 0; bj < 2; ++bj)
#pragma unroll
                    for (int n = 0; n < 2; ++n)
#pragma unroll
                        for (int i = 0; i < 4; ++i) ss += acc[ai][bj][m][n][i] * acc[ai][bj][m][n][i];
                ss = sum_x16_x32(ss);
                const float rinv = __builtin_amdgcn_rsqf(ss * (1.0f / 64.0f) + EPS) * scale;
                const bool lat = row < NLAT; const int t = row & (SEQ - 1);
#pragma unroll
                for (int bj = 0; bj < 2; ++bj) {
                    const f32x4 x1 = acc[ai][bj][m][0] * rinv * g[bj][0], x2 = acc[ai][bj][m][1] * rinv * g[bj][1];
                    const int pos = lat ? (bj ? (t & 63) : (t >> 6)) : 64;
                    const f32x4 c = *(LAS const f32x4*)(cs16 + pos * 16 + 4 * fq), sn = *(LAS const f32x4*)(sn16 + pos * 16 + 4 * fq);
                    bf16_t* p = dst + (size_t)row * pitch + wc * 64 + 32 * bj + 4 * fq;
                    store8(p, x1 * c - x2 * sn); store8(p + 16, x1 * sn + x2 * c);
                }
            }
    }
    DI void head32x2(const AccT& acc, int rbase, int wc, int fq, bf16_t* dst, const float* gain, float scale) const {
        LAS const float* cs8 = rope + 2 * 65 * 16; LAS const float* sn8 = cs8 + 65 * 8;
        const int dbase = 16 * (fq >> 1) + 4 * (fq & 1);
        const f32x4 g0 = *(const f32x4*)(gain + dbase), g1 = *(const f32x4*)(gain + dbase + 8);
#pragma unroll
        for (int ai = 0; ai < 2; ++ai)
#pragma unroll
            for (int m = 0; m < 4; ++m) {
                const int row = rbase + 128 * ai + 16 * m;
                const bool lat = row < NLAT; const int t = row & (SEQ - 1);
                const int pos = lat ? ((fq >> 1) ? (t & 63) : (t >> 6)) : 64;
                const f32x4 c = *(LAS const f32x4*)(cs8 + pos * 8 + 4 * (fq & 1)), sn = *(LAS const f32x4*)(sn8 + pos * 8 + 4 * (fq & 1));
#pragma unroll
                for (int bj = 0; bj < 2; ++bj) {
                    float ss = 0.f;
#pragma unroll
                    for (int n = 0; n < 2; ++n)
#pragma unroll
                        for (int i = 0; i < 4; ++i) ss += acc[ai][bj][m][n][i] * acc[ai][bj][m][n][i];
                    ss = sum_x16_x32(ss);
                    const float rinv = __builtin_amdgcn_rsqf(ss * (1.0f / 32.0f) + EPS) * scale;
                    const f32x4 x1 = acc[ai][bj][m][0] * rinv * g0, x2 = acc[ai][bj][m][1] * rinv * g1;
                    bf16_t* p = dst + (size_t)row * 256 + wc * 64 + 32 * bj + dbase;
                    store8(p, x1 * c - x2 * sn); store8(p + 8, x1 * sn + x2 * c);
                }
            }
    }
    DI void plain(const AccT& acc, int rbase, int wc, int fq, bf16_t* dst) const {
#pragma unroll
        for (int ai = 0; ai < 2; ++ai)
#pragma unroll
            for (int m = 0; m < 4; ++m) {
                const int row = rbase + 128 * ai + 16 * m;
#pragma unroll
                for (int bj = 0; bj < 2; ++bj) store16(dst + (size_t)row * 256 + 128 * bj + 32 * wc + 8 * fq, acc[ai][bj][m][0], acc[ai][bj][m][1]);
            }
    }
    DI void vtrans(const AccT& acc, int rbase, int kvh, int fq, bf16_t* VTA) const {
#pragma unroll
        for (int ai = 0; ai < 2; ++ai)
#pragma unroll
            for (int m = 0; m < 4; ++m) {
                const int row = rbase + 128 * ai + 16 * m; const bool lat = row < NLAT;
                const int b = lat ? (row >> 12) : ((row - NLAT) >> 8), key = lat ? (row & (SEQ - 1)) : SEQ + ((row - NLAT) & (CTX - 1));
                bf16_t* p = VTA + ((size_t)(b * 2 + kvh) * 64 + 8 * fq) * KEYS + key;
#pragma unroll
                for (int bj = 0; bj < 2; ++bj)
#pragma unroll
                    for (int n = 0; n < 2; ++n)
#pragma unroll
                        for (int i = 0; i < 4; ++i) p[(size_t)(32 * bj + 4 * n + i) * KEYS] = (bf16_t)(pk2(acc[ai][bj][m][n][i], 0.f) & 0xffffu);
            }
    }
    DI void operator()(EPI_ARGS) const {
        EPI_OPAQUE();
        const int rbase = u.pm * 256 + wr * 64 + fr;
        if (u.pn == 0) head64(acc, rbase, wc, fq, WSB(bf16_t, WS_QA), 256, kparams()->a_qg + li * 64, C2A);
        else if (u.pn == 1) { if (wc < 2) head64(acc, rbase, wc, fq, WSB(bf16_t, WS_KA), 128, kparams()->a_kg + li * 64, 1.0f); else vtrans(acc, rbase, wc - 2, fq, WSB(bf16_t, WS_VTA)); }
        else if (u.pn == 2) plain(acc, rbase, wc, fq, WSB(bf16_t, WS_BU));
        else if (u.pn == 3) plain(acc, rbase, wc, fq, WSB(bf16_t, WS_BG));
        else if (u.pn == 4) head32x2(acc, rbase, wc, fq, WSB(bf16_t, WS_QD), kparams()->d_qg + li * 32, C2D);
        else head32x2(acc, rbase, wc, fq, WSB(bf16_t, WS_KD), kparams()->d_kg + li * 32, 1.0f);
    }
};
struct SchedProjTok {
    unsigned woff; int G, c; bool last;
    DI bool next(int i, GUnit& u) const { const int L = i * G + c; if (L >= (last ? 128 * 6 + 16 : NTILE_TOK * 6)) return false;
        if (L < 128 * 6 || !last) { u.pm = L / 6; u.pn = L % 6; } else { const int j = L - 128 * 6; u.pm = 128 + (j >> 1); u.pn = (j & 1) ? 5 : 1; }
        u.e = 0; u.A = (unsigned)WS_H + (unsigned)u.pm * (256u * 2048u); u.B = woff + (unsigned)u.pn * (256u * 2048u); return true; }
};

struct EpiProjCh {
    DI void operator()(EPI_ARGS) const {
        EPI_OPAQUE();
        const bool ctx = u.pn >= 128; const int b = ctx ? (u.pn - 128) : (u.pn >> 4); const int t0 = ctx ? 0 : (u.pn & 15) * 256;
        bf16_t* base; size_t pitch; int tokoff;
        if (u.pm == 0) { base = WSB(bf16_t, WS_VTD) + (size_t)b * 4 * 64 * KEYS; pitch = KEYS; tokoff = ctx ? SEQ : t0; }
        else if (!ctx) { base = WSB(bf16_t, WS_FT) + (size_t)b * 256 * 8192; pitch = 8192; tokoff = t0 + (u.pm == 2 ? 4096 : 0); }
        else { base = WSB(bf16_t, WS_FTC) + (size_t)b * 256 * 512; pitch = 512; tokoff = (u.pm == 2 ? 256 : 0); }
#pragma unroll
        for (int ai = 0; ai < 2; ++ai) {
#pragma unroll
            for (int m = 0; m < 4; ++m) {
                const int lrow = 128 * ai + 64 * wr + 16 * m + fr;
#pragma unroll
                for (int bj = 0; bj < 2; ++bj) store16(base + (size_t)lrow * pitch + tokoff + 128 * bj + 32 * wc + 8 * fq, acc[ai][bj][m][0], acc[ai][bj][m][1]);
            }
        }
    }
};
struct SchedProjCh {
    unsigned woff; int G, c; bool last;
    DI bool next(int i, GUnit& u) const { const int L = i * G + c; if (L >= (last ? 128 * 3 + 8 : NTILE_TOK * 3)) return false;
        if (L < 128 * 3 || !last) { u.pn = L / 3; u.pm = L % 3; } else { const int j = L - 128 * 3; u.pn = 128 + j; u.pm = 0; }
        u.e = 0; u.A = woff + (unsigned)u.pm * (256u * 2048u); u.B = (unsigned)WS_H + (unsigned)u.pn * (256u * 2048u); return true; }
};

struct EpiFourier {
    DI void operator()(EPI_ARGS) const {
        EPI_OPAQUE();
        bf16_t* CAT = WSB(bf16_t, WS_CAT);
        const int rbase = u.e + wr * 64 + fr;
#pragma unroll
        for (int ai = 0; ai < 2; ++ai)
#pragma unroll
            for (int m = 0; m < 4; ++m) {
                const int row = rbase + 128 * ai + 16 * m;
#pragma unroll
                for (int bj = 0; bj < 2; ++bj) store16(CAT + (size_t)row * 1024 + 512 + 128 * bj + 32 * wc + 8 * fq, acc[ai][bj][m][0], acc[ai][bj][m][1]);
            }
    }
};
struct SchedFourLat {
    int G, c;
    DI bool next(int i, GUnit& u) const { const int L = i * G + c; if (L >= 128) return false;
        const int b = L >> 4, mt = L & 15; u.pm = mt; u.pn = 0; u.e = b * SEQ + mt * 256; u.A = (unsigned)WS_TL + (unsigned)mt * (256u * 16384u); u.B = (unsigned)WS_FT + (unsigned)b * (256u * 16384u); return true; }
};
struct SchedFourCtx {
    int G, c;
    DI bool next(int i, GUnit& u) const { const int L = i * G + c; if (L >= 8) return false;
        u.pm = 0; u.pn = 0; u.e = NLAT + L * CTX; u.A = (unsigned)WS_TC; u.B = (unsigned)WS_FTC + (unsigned)L * (256u * 1024u); return true; }
};

struct EpiOut {
    int li;
    DI void operator()(EPI_ARGS) const {
        EPI_OPAQUE();
        const float* mod = WSB(const float, WS_MOD) + (size_t)li * 9 * 6144; bf16_t* X1 = WSB(bf16_t, WS_X1);
        const int rbase = u.pm * 256 + wr * 64 + fr, cbase = u.pn * 256 + 64 * wc + 16 * fq;
        const int b9 = (u.pm < 128) ? (u.pm >> 4) : 8;
        f32x4 g[2][2];
#pragma unroll
        for (int bj = 0; bj < 2; ++bj)
#pragma unroll
            for (int n = 0; n < 2; ++n) g[bj][n] = *(const f32x4*)(mod + b9 * 6144 + 2048 + cbase + 8 * bj + 4 * n);
        if (li == 0) {
            KParamsPtr kp = kparams(); const float* xb = (u.pm < 128) ? kp->x : kp->ctx - (size_t)NLAT * 1024;
#pragma unroll
            for (int ai = 0; ai < 2; ++ai) {
                f32x4 xv[4][2][2];
#pragma unroll
                for (int m = 0; m < 4; ++m)
#pragma unroll
                    for (int bj = 0; bj < 2; ++bj)
#pragma unroll
                        for (int n = 0; n < 2; ++n) xv[m][bj][n] = *(const f32x4*)(xb + (size_t)(rbase + 128 * ai + 16 * m) * 1024 + cbase + 8 * bj + 4 * n);
#pragma unroll
                for (int m = 0; m < 4; ++m)
#pragma unroll
                    for (int bj = 0; bj < 2; ++bj) store16(X1 + (size_t)(rbase + 128 * ai + 16 * m) * 1024 + cbase + 8 * bj, xv[m][bj][0] + g[bj][0] * acc[ai][bj][m][0], xv[m][bj][1] + g[bj][1] * acc[ai][bj][m][1]);
            }
        } else {
            const bf16_t* X2 = WSB(const bf16_t, WS_X2);
            u32x4 xv[2][4][2];
#pragma unroll
            for (int ai = 0; ai < 2; ++ai)
#pragma unroll
                for (int m = 0; m < 4; ++m)
#pragma unroll
                    for (int bj = 0; bj < 2; ++bj) xv[ai][m][bj] = *(const u32x4*)(X2 + (size_t)(rbase + 128 * ai + 16 * m) * 1024 + cbase + 8 * bj);
#pragma unroll
            for (int ai = 0; ai < 2; ++ai)
#pragma unroll
                for (int m = 0; m < 4; ++m)
#pragma unroll
                    for (int bj = 0; bj < 2; ++bj) { const u32x4 xi = xv[ai][m][bj];
                        store16(X1 + (size_t)(rbase + 128 * ai + 16 * m) * 1024 + cbase + 8 * bj,
                                (f32x4){bflo(xi.x), bfhi(xi.x), bflo(xi.y), bfhi(xi.y)} + g[bj][0] * acc[ai][bj][m][0], (f32x4){bflo(xi.z), bfhi(xi.z), bflo(xi.w), bfhi(xi.w)} + g[bj][1] * acc[ai][bj][m][1]); }
        }
    }
};
struct SchedOut {
    unsigned woff; int G, c, npanel;
    DI bool next(int i, GUnit& u) const { const int L = i * G + c; if (L >= npanel * 4) return false;
        u.pm = L / 4; u.pn = L % 4; u.e = 0; u.A = (unsigned)WS_CAT + (unsigned)u.pm * (256u * 2048u); u.B = woff + (unsigned)u.pn * (256u * 2048u); return true; }
};

struct EpiMoe1 {
    int li;
    DI void operator()(EPI_ARGS) const {
        EPI_OPAQUE();
        unsigned char* ACT = WSB(unsigned char, WS_ACT);
        const int rbase = u.pm * 256 + wr * 64 + fr, cbase = u.pn * 128 + 32 * wc + 8 * fq;
        const float* bb = kparams()->b_gu + ((size_t)li * NE + u.e) * 2048 + cbase;
        f32x4 bg[2], bu1[2];
#pragma unroll
        for (int n = 0; n < 2; ++n) { bg[n] = *(const f32x4*)(bb + 4 * n); bu1[n] = *(const f32x4*)(bb + 1024 + 4 * n) + 1.0f; }
#pragma unroll
        for (int ai = 0; ai < 2; ++ai)
#pragma unroll
            for (int m = 0; m < 4; ++m) {
                const int row = rbase + 128 * ai + 16 * m;
                f32x4 o[2];
#pragma unroll
                for (int n = 0; n < 2; ++n) {
                    const f32x4 gg = acc[ai][0][m][n] * W8_INV + bg[n], uu = acc[ai][1][m][n] * W8_INV + bu1[n];
                    f32x4 gv, u1, e;
#pragma unroll
                    for (int i = 0; i < 4; ++i) { gv[i] = fminf(gg[i], 7.0f); u1[i] = __builtin_amdgcn_fmed3f(uu[i], -6.0f, 8.0f); }
                    const f32x4 t = gv * (-1.702f * LOG2E);
#pragma unroll
                    for (int i = 0; i < 4; ++i) e[i] = __builtin_amdgcn_exp2f(t[i]);
                    const f32x4 d = e + 1.0f;
                    f32x4 r;
#pragma unroll
                    for (int i = 0; i < 4; ++i) r[i] = __builtin_amdgcn_rcpf(d[i]);
                    o[n] = gv * u1 * r;
                }
                u32x2 w; w.x = pk4_fp8(o[0][0], o[0][1], o[0][2], o[0][3]); w.y = pk4_fp8(o[1][0], o[1][1], o[1][2], o[1][3]);
                *(u32x2*)(ACT + (size_t)row * 1024 + cbase) = w;
            }
    }
};
struct EpiMoe2 {
    int li;
    DI void operator()(EPI_ARGS) const {
        EPI_OPAQUE();
        unsigned char* YB = WSB(unsigned char, WS_XP) + (size_t)MAXMT * 256 * 1024;
        const int rbase = u.pm * 256 + wr * 64 + fr, cbase = u.pn * 256 + 64 * wc + 16 * fq;
        const float* bb = kparams()->b_dn + ((size_t)li * NE + u.e) * 1024 + cbase;
        f32x4 bv[2][2];
#pragma unroll
        for (int bj = 0; bj < 2; ++bj)
#pragma unroll
            for (int n = 0; n < 2; ++n) bv[bj][n] = *(const f32x4*)(bb + 8 * bj + 4 * n);
#pragma unroll
        for (int ai = 0; ai < 2; ++ai)
#pragma unroll
            for (int m = 0; m < 4; ++m) {
                const int row = rbase + 128 * ai + 16 * m;
                u32x4 w;
#pragma unroll
                for (int bj = 0; bj < 2; ++bj)
#pragma unroll
                    for (int n = 0; n < 2; ++n) { const f32x4 a = acc[ai][bj][m][n] * W8_INV + bv[bj][n]; w[2 * bj + n] = pk4_fp8(clamp448(a[0]), clamp448(a[1]), clamp448(a[2]), clamp448(a[3])); }
                *(u32x4*)(YB + (size_t)row * 1024 + cbase) = w;
            }
    }
};
template <int nN, bool GATH = false> struct SchedMoe {
    unsigned aoff, woff, wstride_e; const LAS int* tab; int G, c;
    DI bool next(int i, GUnit& u) const { const int NT = __builtin_amdgcn_readfirstlane(tab[0]);
        if ((G & 7) == 0) { const int idx = i * (G >> 3) + (c >> 3), per = (NT + 7) >> 3, loc = idx / nN; u.pm = (c & 7) * per + loc; u.pn = idx % nN; if (loc >= per || u.pm >= NT) return false; }
        else { const int L = i * G + c; if (L >= NT * nN) return false; u.pm = L / nN; u.pn = L % nN; }
        u.e = __builtin_amdgcn_readfirstlane(tab[64 + u.pm]);
        u.A = GATH ? (unsigned)(u.e * NTOK + (u.pm * 256 - __builtin_amdgcn_readfirstlane(tab[32 + u.e]))) : aoff + (unsigned)u.pm * (256u * 1024u);
        u.B = woff + (unsigned)u.e * wstride_e + (unsigned)u.pn * (256u * 1024u); return true; }
};

DI int invperm32(int c);
DI int fwd_gu(int n);
DI int fwd_lane16(int c);
DI int fwd_dn(int n);
constexpr int AT_ROWB = 144;
constexpr int AT_VROWB = 136;
constexpr int AT_TILEB = 64 * AT_ROWB;
constexpr int AT_BUFB = AT_TILEB + 64 * AT_VROWB + 128;
struct AttnArgs {
    const bf16_t* q;
    const bf16_t* klat;
    const bf16_t* kctx;
    int kpitch;
    const bf16_t* vt;
    int t0, t1;
    bf16_t* out;
    float lam, oscale; const float* subg;
    int wl, wli;
};
constexpr int AT_NWT = 24;
constexpr int AT_WT = 55296;
DI f32x16 mfma32(bf16x8 a, bf16x8 b, f32x16 c) { return __builtin_amdgcn_mfma_f32_32x32x16_bf16(a, b, c, 0, 0, 0); }
DI bf16x8 packp(const f32x16& x, int s) { u32x4 p; p.x = pk2(x[8 * s], x[8 * s + 1]); p.y = pk2(x[8 * s + 2], x[8 * s + 3]); p.z = pk2(x[8 * s + 4], x[8 * s + 5]); p.w = pk2(x[8 * s + 6], x[8 * s + 7]); return __builtin_bit_cast(bf16x8, p); }

template <bool DIFF>
DI void attn_unit(unsigned char* lds, const AttnArgs& a) {
    int tid = threadIdx.x; asm volatile("" : "+v"(tid));
    const int lane = tid & 63, r = lane & 31, h = lane >> 5; const int wid = __builtin_amdgcn_readfirstlane(tid >> 6);
    bf16x8 qf[4];
    { const bf16_t* qp = a.q + (size_t)(wid * 32 + r) * 256 + 8 * h;
#pragma unroll
      for (int x = 0; x < 4; ++x) qf[x] = *(const bf16x8*)(qp + 16 * x); }
    const int lrow = tid >> 3, lch = tid & 7;
    const bf16_t* vsrc = a.vt + (size_t)lrow * KEYS + 8 * lch;
    const int ldst = lrow * AT_ROWB + lch * 16, ldstv = AT_TILEB + lrow * AT_VROWB + lch * 16;
    const int koff = r * AT_ROWB + 16 * h;
    const int voff = AT_TILEB + r * AT_VROWB + 8 * h;
    f32x16 o0[2], o1[2];
#pragma unroll
    for (int d = 0; d < 2; ++d) { o0[d] = (f32x16){}; o1[d] = (f32x16){}; }
    f32x4 l0 = {0.f, 0.f, 0.f, 0.f}, l1 = {0.f, 0.f, 0.f, 0.f};
    u32x4 kregA, vregA, kregB, vregB;
    auto gload = [&](int t, u32x4& kreg, u32x4& vreg) __attribute__((always_inline)) {
        const bf16_t* kp = (t < 64) ? a.klat + (size_t)(t * 64 + lrow) * a.kpitch : a.kctx + (size_t)((t - 64) * 64 + lrow) * a.kpitch;
        kreg = *(const u32x4*)(kp + 8 * lch);
        vreg = *(const u32x4*)(vsrc + (size_t)t * 64);
    };
    auto lstore = [&](int slot, const u32x4& kreg, const u32x4& vreg) __attribute__((always_inline)) { unsigned char* b = lds + slot * AT_BUFB; *(u32x4*)(b + ldst) = kreg; *(u32x2*)(b + ldstv) = (u32x2){vreg.x, vreg.y}; *(u32x2*)(b + ldstv + 8) = (u32x2){vreg.z, vreg.w}; };
    auto kread = [&](const unsigned char* Kb, int hh, bf16x8 (&kf)[4]) __attribute__((always_inline)) {
#pragma unroll
        for (int x = 0; x < 4; ++x) kf[x] = *(const bf16x8*)(Kb + koff + hh * 32 * AT_ROWB + 32 * x); };
    auto vread = [&](const unsigned char* Vb, int hh, bf16x8 (&vf)[2][2]) __attribute__((always_inline)) {
#pragma unroll
        for (int s2 = 0; s2 < 2; ++s2)
#pragma unroll
            for (int d = 0; d < 2; ++d) { const unsigned char* vp = Vb + voff + d * 32 * AT_VROWB + 64 * hh + 32 * s2;
                const s16x4 lo = *(const s16x4*)vp, hi = *(const s16x4*)(vp + 16); vf[s2][d] = __builtin_shufflevector(lo, hi, 0, 1, 2, 3, 4, 5, 6, 7); } };
    auto qk = [&](const bf16x8 (&kf)[4], f32x16& sa, f32x16& sb) __attribute__((always_inline)) {
        if (!DIFF) { sa = mfma32(kf[0], qf[0], (f32x16){}); sa = mfma32(kf[1], qf[1], sa); sa = mfma32(kf[2], qf[2], sa); sa = mfma32(kf[3], qf[3], sa); }
        else { sa = mfma32(kf[0], qf[0], (f32x16){}); sb = mfma32(kf[2], qf[2], (f32x16){}); sa = mfma32(kf[1], qf[1], sa); sb = mfma32(kf[3], qf[3], sb); }
    };
    auto expsum = [&](f32x16& sc, f32x4& l) __attribute__((always_inline)) {
#pragma unroll
        for (int i = 0; i < 16; ++i) sc[i] = __builtin_amdgcn_exp2f(sc[i]);
#pragma unroll
        for (int i = 0; i < 4; ++i) l += (f32x4){sc[4 * i], sc[4 * i + 1], sc[4 * i + 2], sc[4 * i + 3]};
    };
    auto pv1 = [&](const bf16x8 (&vf)[2][2], const f32x16& pa, f32x16 (&o)[2]) __attribute__((always_inline)) {
#pragma unroll
        for (int s2 = 0; s2 < 2; ++s2) { const bf16x8 pp = packp(pa, s2); o[0] = mfma32(vf[s2][0], pp, o[0]); o[1] = mfma32(vf[s2][1], pp, o[1]); }
    };
    f32x4 wq[4];
    const int wn4 = (tid & 63) * 4;
    constexpr int WPITCH = 36;
    auto w_decode = [&](int j, const float*& src, unsigned char*& dst, int& ld, int& n0, int& k0, bool& gu) __attribute__((always_inline)) {
        const int g = (j >> 2) * 512 + a.wl, e = g / 96, r = g - e * 96; KParamsPtr kp = kparams();
        if (r < 64) { src = kp->w_gu + ((size_t)a.wli * NE + e) * (1024 * 2048); dst = kp->ws + WS_WGU + (size_t)a.wli * SZ_WGU + (size_t)e * 2048 * 1024; ld = 2048; n0 = (r & 7) * 256; k0 = ((r >> 3) * 4 + (j & 3)) * 32; gu = true; }
        else { const int q = r - 64; src = kp->w_dn + ((size_t)a.wli * NE + e) * (1024 * 1024); dst = kp->ws + WS_WDN + (size_t)a.wli * SZ_WDN + (size_t)e * 1024 * 1024; ld = 1024; n0 = (q & 3) * 256; k0 = ((q >> 2) * 4 + (j & 3)) * 32; gu = false; } };
    auto w_issue = [&](int j) __attribute__((always_inline)) { const float* src; unsigned char* dst; int ld, n0, k0; bool gu; w_decode(j, src, dst, ld, n0, k0, gu);
        const float* p = src + (size_t)(k0 + 4 * wid) * ld + n0 + wn4;
        wq[0] = __builtin_nontemporal_load((const f32x4*)p); wq[1] = __builtin_nontemporal_load((const f32x4*)(p + ld));
        wq[2] = __builtin_nontemporal_load((const f32x4*)(p + (size_t)2 * ld)); wq[3] = __builtin_nontemporal_load((const f32x4*)(p + (size_t)3 * ld)); };
    auto w_cvt = [&]() __attribute__((always_inline)) { unsigned char* t8 = lds + AT_WT + wn4 * WPITCH + 4 * wid;
#pragma unroll
        for (int j = 0; j < 4; ++j) *(unsigned*)(t8 + j * WPITCH) = pk4_fp8(wq[0][j] * W8_SCALE, wq[1][j] * W8_SCALE, wq[2][j] * W8_SCALE, wq[3][j] * W8_SCALE); };
    auto w_store = [&](int j) __attribute__((always_inline)) { const float* src; unsigned char* dst; int ld, n0, k0; bool gu; w_decode(j, src, dst, ld, n0, k0, gu);
        const int col = tid >> 1, half = tid & 1, n = n0 + col; const int p = gu ? fwd_gu(n) : fwd_dn(n);
        const unsigned* t = (const unsigned*)(lds + AT_WT + col * WPITCH + 16 * half);
        *(u32x4*)(dst + (size_t)p * 1024 + k0 + 16 * half) = (u32x4){t[0], t[1], t[2], t[3]}; };
    const bool wrider = !DIFF && a.wl >= 0;
    if (wrider) w_issue(0);
    gload(a.t0, kregA, vregA); gload(a.t0 + 1 < a.t1 ? a.t0 + 1 : a.t0, kregB, vregB);
    lstore(0, kregA, vregA); lstore(1, kregB, vregB);
    __syncthreads();
    asm volatile("" : "+v"(qf[0]), "+v"(qf[1]), "+v"(qf[2]), "+v"(qf[3]));
    if (!DIFF && a.t0 + 2 < a.t1) gload(a.t0 + 2, kregA, vregA);
    f32x16 s0a, s0b, s1a, s1b; s0b = (f32x16){}; s1b = (f32x16){};
    bf16x8 kf[4], vf[2][2];
    kread(lds, 0, kf); qk(kf, s0a, s0b);
    int slot = 0;
    auto step = [&](int t, u32x4& kl, u32x4& vl, const u32x4& ks, const u32x4& vs, const int hk, const int wj) __attribute__((always_inline)) {
        const int slot1 = slot == 2 ? 0 : slot + 1, slot2 = slot1 == 2 ? 0 : slot1 + 1;
        if (!DIFF && hk == 1) { w_cvt(); w_issue(wj + 1 < AT_NWT ? wj + 1 : AT_NWT - 1); }
        if (!DIFF && hk == 2) w_store(wj);
        { const int tn = t + (DIFF ? 2 : 3); gload(tn < a.t1 ? tn : a.t1 - 1, kl, vl); }
        const unsigned char* Kb = lds + slot * AT_BUFB;
        if (!DIFF) {
            kread(Kb, 1, kf); vread(Kb, 0, vf);
            qk(kf, s1a, s1b);
            expsum(s0a, l0);
            pv1(vf, s0a, o0);
            kread(lds + slot1 * AT_BUFB, 0, kf);
            vread(Kb, 1, vf);
            qk(kf, s0a, s0b);
            expsum(s1a, l0);
            pv1(vf, s1a, o0);
        } else {
            kread(Kb, 1, kf); vread(Kb, 0, vf);
            qk(kf, s1a, s1b);
            expsum(s0a, l0); expsum(s0b, l1);
            pv1(vf, s0a, o0); pv1(vf, s0b, o1);
            kread(lds + slot1 * AT_BUFB, 0, kf);
            vread(Kb, 1, vf);
            qk(kf, s0a, s0b);
            expsum(s1a, l0); expsum(s1b, l1);
            pv1(vf, s1a, o0); pv1(vf, s1b, o1);
        }
        lstore(slot2, ks, vs);
        __syncthreads();
        slot = slot1;
    };
    if (DIFF) { for (int t = a.t0; t < a.t1; ++t) step(t, kregA, vregA, kregA, vregA, 0, 0); }
    else {
        int t = a.t0;
        if (wrider)
            for (int j = 0; j < AT_NWT; ++j, t += 2) { step(t, kregB, vregB, kregA, vregA, 1, j); step(t + 1, kregA, vregA, kregB, vregB, 2, j); }
        for (; t < a.t1; t += 2) {
            step(t, kregB, vregB, kregA, vregA, 0, 0);
            if (t + 1 < a.t1) step(t + 1, kregA, vregA, kregB, vregB, 0, 0);
        }
    }
    float lt0 = l0[0] + l0[1] + l0[2] + l0[3];
    lt0 += __shfl_xor(lt0, 32);
    bf16_t* op = a.out + (size_t)(wid * 32 + r) * 1024 + 4 * h;
    if (!DIFF) {
        const float rl = 1.0f / lt0;
#pragma unroll
        for (int d = 0; d < 2; ++d)
#pragma unroll
            for (int g = 0; g < 4; ++g) { f32x4 v = {o0[d][4 * g] * rl, o0[d][4 * g + 1] * rl, o0[d][4 * g + 2] * rl, o0[d][4 * g + 3] * rl}; store8(op + 32 * d + 8 * g, v); }
    } else {
        float lt1 = l1[0] + l1[1] + l1[2] + l1[3];
        lt1 += __shfl_xor(lt1, 32);
        const float r0 = 1.0f / lt0, r1 = a.lam / lt1;
        float ss = 0.f;
#pragma unroll
        for (int d = 0; d < 2; ++d)
#pragma unroll
            for (int i = 0; i < 16; ++i) { const float v = o0[d][i] * r0 - o1[d][i] * r1; o0[d][i] = v; ss += v * v; }
        ss += __shfl_xor(ss, 32);
        const float rinv = rsqrtf(ss * (1.0f / 64.0f) + EPS) * a.oscale;
        f32x4 ggv[2][4];
#pragma unroll
        for (int d = 0; d < 2; ++d)
#pragma unroll
            for (int g = 0; g < 4; ++g) ggv[d][g] = *(const f32x4*)(a.subg + 32 * d + 8 * g + 4 * h);
        asm volatile("" : "+v"(ggv[0][0]), "+v"(ggv[1][3]));
#pragma unroll
        for (int d = 0; d < 2; ++d)
#pragma unroll
            for (int g = 0; g < 4; ++g) { const f32x4 gg = ggv[d][g];
                f32x4 v = {o0[d][4 * g] * rinv * gg[0], o0[d][4 * g + 1] * rinv * gg[1], o0[d][4 * g + 2] * rinv * gg[2], o0[d][4 * g + 3] * rinv * gg[3]}; store8(op + 32 * d + 8 * g, v); }
    }
}

constexpr int A8_PITCH = 80;
constexpr int A8_VOFF = 64 * A8_PITCH;
typedef short v2s_t __attribute__((ext_vector_type(2)));
DI unsigned pk4_fp8_div16(float a, float b, float c, float d) { v2s_t r = {0, 0}; r = __builtin_amdgcn_cvt_scalef32_pk_fp8_f32(r, a, b, 16.0f, false); r = __builtin_amdgcn_cvt_scalef32_pk_fp8_f32(r, c, d, 16.0f, true); return __builtin_bit_cast(unsigned, r); }
DI f32x16 mfma8(v8i a, v8i b, f32x16 c) { return __builtin_amdgcn_mfma_scale_f32_32x32x64_f8f6f4(a, b, c, 0, 0, 0, 0, 0, 0); }
DI u32x2 bf8_to_fp8(u32x4 v) {
    int d0 = 0, d1 = 0;
    d0 = __builtin_amdgcn_cvt_pk_fp8_f32(bflo(v.x), bfhi(v.x), d0, false); d0 = __builtin_amdgcn_cvt_pk_fp8_f32(bflo(v.y), bfhi(v.y), d0, true);
    d1 = __builtin_amdgcn_cvt_pk_fp8_f32(bflo(v.z), bfhi(v.z), d1, false); d1 = __builtin_amdgcn_cvt_pk_fp8_f32(bflo(v.w), bfhi(v.w), d1, true);
    return (u32x2){(unsigned)d0, (unsigned)d1};
}
DI void attn_unit_a8(unsigned char* lds, const AttnArgs& a) {
    int tid = threadIdx.x; asm volatile("" : "+v"(tid));
    const int lane = tid & 63, r = lane & 31, h = lane >> 5; const int wid = __builtin_amdgcn_readfirstlane(tid >> 6);
    v8i qf8;
    { const bf16_t* qp = a.q + (size_t)(wid * 32 + r) * 256 + 32 * h;
      const u32x4 q0 = *(const u32x4*)qp, q1 = *(const u32x4*)(qp + 8), q2 = *(const u32x4*)(qp + 16), q3 = *(const u32x4*)(qp + 24);
      const u32x2 c0 = bf8_to_fp8(q0), c1 = bf8_to_fp8(q1), c2 = bf8_to_fp8(q2), c3 = bf8_to_fp8(q3);
      qf8 = (v8i){(int)c0.x, (int)c0.y, (int)c1.x, (int)c1.y, (int)c2.x, (int)c2.y, (int)c3.x, (int)c3.y}; }
    const int lrow = tid >> 3, lch = tid & 7;
    const bf16_t* vsrc = a.vt + (size_t)lrow * KEYS + 8 * lch;
    const int ldk = lrow * A8_PITCH + 8 * lch;
    const int ldv = A8_VOFF + lrow * A8_PITCH + (lch >> 2) * 16 + (lch & 3) * 4;
    const int koff = r * A8_PITCH + 32 * h, voff = A8_VOFF + r * A8_PITCH + 32 * h;
    f32x16 o0[2]; o0[0] = (f32x16){}; o0[1] = (f32x16){};
    f32x4 l0 = {0.f, 0.f, 0.f, 0.f};
    u32x4 kregA, vregA, kregB, vregB;
    auto gload = [&](int t, u32x4& kreg, u32x4& vreg) __attribute__((always_inline)) {
        const bf16_t* kp = (t < 64) ? a.klat + (size_t)(t * 64 + lrow) * a.kpitch : a.kctx + (size_t)((t - 64) * 64 + lrow) * a.kpitch;
        kreg = *(const u32x4*)(kp + 8 * lch);
        vreg = *(const u32x4*)(vsrc + (size_t)t * 64);
    };
    auto lstore = [&](int slot, const u32x4& kreg, const u32x4& vreg) __attribute__((always_inline)) { unsigned char* b = lds + slot * AT_BUFB;
        *(u32x2*)(b + ldk) = bf8_to_fp8(kreg); const u32x2 v8 = bf8_to_fp8(vreg); *(unsigned*)(b + ldv) = v8.x; *(unsigned*)(b + ldv + 32) = v8.y; };
    auto rd32 = [&](const unsigned char* p) __attribute__((always_inline)) -> v8i { const u32x4 lo = *(const u32x4*)p, hi = *(const u32x4*)(p + 16);
        return (v8i){(int)lo.x, (int)lo.y, (int)lo.z, (int)lo.w, (int)hi.x, (int)hi.y, (int)hi.z, (int)hi.w}; };
    auto kread = [&](const unsigned char* Kb, int hh) __attribute__((always_inline)) -> v8i { return rd32(Kb + koff + hh * 32 * A8_PITCH); };
    auto vread = [&](const unsigned char* Vb, int dblk) __attribute__((always_inline)) -> v8i { return rd32(Vb + voff + dblk * 32 * A8_PITCH); };
    const f32x16 cinit = (f32x16){};
    auto expsum = [&](f32x16& sc) __attribute__((always_inline)) {
#pragma unroll
        for (int i = 0; i < 16; ++i) sc[i] = __builtin_amdgcn_exp2f(sc[i]);
#pragma unroll
        for (int i = 0; i < 4; ++i) l0 += (f32x4){sc[4 * i], sc[4 * i + 1], sc[4 * i + 2], sc[4 * i + 3]};
    };
    auto pack8 = [&](const f32x16& s0, const f32x16& s1) __attribute__((always_inline)) -> v8i { v8i p;
#pragma unroll
        for (int g = 0; g < 4; ++g) { p[g] = (int)pk4_fp8_div16(s0[4 * g], s0[4 * g + 1], s0[4 * g + 2], s0[4 * g + 3]); p[4 + g] = (int)pk4_fp8_div16(s1[4 * g], s1[4 * g + 1], s1[4 * g + 2], s1[4 * g + 3]); }
        return p; };
    f32x4 wq[4];
    const int wn4 = (tid & 63) * 4;
    constexpr int WPITCH = 36;
    auto w_decode = [&](int j, const float*& src, unsigned char*& dst, int& ld, int& n0, int& k0, bool& gu) __attribute__((always_inline)) {
        const int g = (j >> 2) * 512 + a.wl, e = g / 96, rr = g - e * 96; KParamsPtr kp = kparams();
        if (rr < 64) { src = kp->w_gu + ((size_t)a.wli * NE + e) * (1024 * 2048); dst = kp->ws + WS_WGU + (size_t)a.wli * SZ_WGU + (size_t)e * 2048 * 1024; ld = 2048; n0 = (rr & 7) * 256; k0 = ((rr >> 3) * 4 + (j & 3)) * 32; gu = true; }
        else { const int q = rr - 64; src = kp->w_dn + ((size_t)a.wli * NE + e) * (1024 * 1024); dst = kp->ws + WS_WDN + (size_t)a.wli * SZ_WDN + (size_t)e * 1024 * 1024; ld = 1024; n0 = (q & 3) * 256; k0 = ((q >> 2) * 4 + (j & 3)) * 32; gu = false; } };
    auto w_issue = [&](int j) __attribute__((always_inline)) { const float* src; unsigned char* dst; int ld, n0, k0; bool gu; w_decode(j, src, dst, ld, n0, k0, gu);
        const float* p = src + (size_t)(k0 + 4 * wid) * ld + n0 + wn4;
        wq[0] = __builtin_nontemporal_load((const f32x4*)p); wq[1] = __builtin_nontemporal_load((const f32x4*)(p + ld));
        wq[2] = __builtin_nontemporal_load((const f32x4*)(p + (size_t)2 * ld)); wq[3] = __builtin_nontemporal_load((const f32x4*)(p + (size_t)3 * ld)); };
    auto w_cvt = [&]() __attribute__((always_inline)) { unsigned char* t8 = lds + AT_WT + wn4 * WPITCH + 4 * wid;
#pragma unroll
        for (int j = 0; j < 4; ++j) *(unsigned*)(t8 + j * WPITCH) = pk4_fp8(wq[0][j] * W8_SCALE, wq[1][j] * W8_SCALE, wq[2][j] * W8_SCALE, wq[3][j] * W8_SCALE); };
    auto w_store = [&](int j) __attribute__((always_inline)) { const float* src; unsigned char* dst; int ld, n0, k0; bool gu; w_decode(j, src, dst, ld, n0, k0, gu);
        const int col = tid >> 1, half = tid & 1, n = n0 + col; const int p = gu ? fwd_gu(n) : fwd_dn(n);
        const unsigned* t = (const unsigned*)(lds + AT_WT + col * WPITCH + 16 * half);
        *(u32x4*)(dst + (size_t)p * 1024 + k0 + 16 * half) = (u32x4){t[0], t[1], t[2], t[3]}; };
    const bool wrider = a.wl >= 0;
    if (wrider) w_issue(0);
    gload(a.t0, kregA, vregA); gload(a.t0 + 1 < a.t1 ? a.t0 + 1 : a.t0, kregB, vregB);
    lstore(0, kregA, vregA); lstore(1, kregB, vregB);
    __syncthreads();
    asm volatile("" : "+v"(qf8));
    if (a.t0 + 2 < a.t1) gload(a.t0 + 2, kregA, vregA);
    f32x16 sx0, sx1, sy0, sy1;
    sx0 = mfma8(kread(lds, 0), qf8, cinit); sx1 = mfma8(kread(lds, 1), qf8, cinit);
    int slot = 0;
    auto step = [&](int t, u32x4& kl, u32x4& vl, const u32x4& ks, const u32x4& vs, f32x16& c0, f32x16& c1, f32x16& n0, f32x16& n1, const int hk, const int wj) __attribute__((always_inline)) {
        const int slot1 = slot == 2 ? 0 : slot + 1, slot2 = slot1 == 2 ? 0 : slot1 + 1;
        if (hk == 1) { w_cvt(); w_issue(wj + 1 < AT_NWT ? wj + 1 : AT_NWT - 1); }
        if (hk == 2) w_store(wj);
        { const int tn = t + 3; gload(tn < a.t1 ? tn : a.t1 - 1, kl, vl); }
        const unsigned char* Kb = lds + slot * AT_BUFB; const unsigned char* Kn = lds + slot1 * AT_BUFB;
        const v8i k0 = kread(Kn, 0), k1 = kread(Kn, 1), v0 = vread(Kb, 0), v1 = vread(Kb, 1);
        n0 = mfma8(k0, qf8, cinit); n1 = mfma8(k1, qf8, cinit);
        expsum(c0); expsum(c1);
        const v8i P = pack8(c0, c1);
        o0[0] = mfma8(v0, P, o0[0]); o0[1] = mfma8(v1, P, o0[1]);
        lstore(slot2, ks, vs);
        __syncthreads();
        slot = slot1;
    };
    {
        int t = a.t0;
        if (wrider)
            for (int j = 0; j < AT_NWT; ++j, t += 2) { step(t, kregB, vregB, kregA, vregA, sx0, sx1, sy0, sy1, 1, j); step(t + 1, kregA, vregA, kregB, vregB, sy0, sy1, sx0, sx1, 2, j); }
        for (; t < a.t1; t += 2) {
            step(t, kregB, vregB, kregA, vregA, sx0, sx1, sy0, sy1, 0, 0);
            if (t + 1 < a.t1) step(t + 1, kregA, vregA, kregB, vregB, sy0, sy1, sx0, sx1, 0, 0);
            else { sx0 = sy0; sx1 = sy1; }
        }
    }
    float lt0 = l0[0] + l0[1] + l0[2] + l0[3];
    lt0 += __shfl_xor(lt0, 32);
    bf16_t* op = a.out + (size_t)(wid * 32 + r) * 1024 + 4 * h;
    const float rl = 16.0f / lt0;
#pragma unroll
    for (int d = 0; d < 2; ++d)
#pragma unroll
        for (int g = 0; g < 4; ++g) { f32x4 v = {o0[d][4 * g] * rl, o0[d][4 * g + 1] * rl, o0[d][4 * g + 2] * rl, o0[d][4 * g + 3] * rl}; store8(op + 32 * d + 8 * g, v); }
}

DI void attn_unit_d8(unsigned char* lds, const AttnArgs& a) {
    int tid = threadIdx.x; asm volatile("" : "+v"(tid));
    const int lane = tid & 63, r = lane & 31, h = lane >> 5; const int wid = __builtin_amdgcn_readfirstlane(tid >> 6);
    bf16x8 qf[4];
    { const bf16_t* qp = a.q + (size_t)(wid * 32 + r) * 256 + 8 * h;
#pragma unroll
      for (int x = 0; x < 4; ++x) qf[x] = *(const bf16x8*)(qp + 16 * x); }
    const int lrow = tid >> 3, lch = tid & 7;
    const bf16_t* vsrc = a.vt + (size_t)lrow * KEYS + 8 * lch;
    const int ldst = lrow * AT_ROWB + lch * 16;
    const int ldv = AT_TILEB + lrow * A8_PITCH + (lch >> 2) * 16 + (lch & 3) * 4;
    const int koff = r * AT_ROWB + 16 * h, voff = AT_TILEB + r * A8_PITCH + 32 * h;
    f32x16 o0[2], o1[2];
#pragma unroll
    for (int d = 0; d < 2; ++d) { o0[d] = (f32x16){}; o1[d] = (f32x16){}; }
    f32x4 l0 = {0.f, 0.f, 0.f, 0.f}, l1 = {0.f, 0.f, 0.f, 0.f};
    u32x4 kreg, vreg;
    auto gload = [&](int t) __attribute__((always_inline)) {
        const bf16_t* kp = (t < 64) ? a.klat + (size_t)(t * 64 + lrow) * a.kpitch : a.kctx + (size_t)((t - 64) * 64 + lrow) * a.kpitch;
        kreg = *(const u32x4*)(kp + 8 * lch);
        vreg = *(const u32x4*)(vsrc + (size_t)t * 64);
    };
    auto lstore = [&](int slot) __attribute__((always_inline)) { unsigned char* b = lds + slot * AT_BUFB;
        *(u32x4*)(b + ldst) = kreg; const u32x2 v8 = bf8_to_fp8(vreg); *(unsigned*)(b + ldv) = v8.x; *(unsigned*)(b + ldv + 32) = v8.y; };
    auto rd32 = [&](const unsigned char* p) __attribute__((always_inline)) -> v8i { const u32x4 lo = *(const u32x4*)p, hi = *(const u32x4*)(p + 16);
        return (v8i){(int)lo.x, (int)lo.y, (int)lo.z, (int)lo.w, (int)hi.x, (int)hi.y, (int)hi.z, (int)hi.w}; };
    auto expsum = [&](f32x16& sc, f32x4& l) __attribute__((always_inline)) {
#pragma unroll
        for (int i = 0; i < 16; ++i) sc[i] = __builtin_amdgcn_exp2f(sc[i]);
#pragma unroll
        for (int i = 0; i < 4; ++i) l += (f32x4){sc[4 * i], sc[4 * i + 1], sc[4 * i + 2], sc[4 * i + 3]};
    };
    auto pack8 = [&](const f32x16& s0, const f32x16& s1) __attribute__((always_inline)) -> v8i { v8i p;
#pragma unroll
        for (int g = 0; g < 4; ++g) { p[g] = (int)pk4_fp8_div16(s0[4 * g], s0[4 * g + 1], s0[4 * g + 2], s0[4 * g + 3]); p[4 + g] = (int)pk4_fp8_div16(s1[4 * g], s1[4 * g + 1], s1[4 * g + 2], s1[4 * g + 3]); }
        return p; };
    auto pack4 = [&](const f32x16& sc, v8i& p, const int o) __attribute__((always_inline)) {
#pragma unroll
        for (int g = 0; g < 4; ++g) p[o + g] = (int)pk4_fp8_div16(sc[4 * g], sc[4 * g + 1], sc[4 * g + 2], sc[4 * g + 3]); };
    auto qk = [&](const unsigned char* Kb, int hh, f32x16& sa, f32x16& sb) __attribute__((always_inline)) { bf16x8 kf[4];
#pragma unroll
        for (int x = 0; x < 4; ++x) kf[x] = *(const bf16x8*)(Kb + koff + hh * 32 * AT_ROWB + 32 * x);
        sa = mfma32(kf[0], qf[0], (f32x16){}); sb = mfma32(kf[2], qf[2], (f32x16){}); sa = mfma32(kf[1], qf[1], sa); sb = mfma32(kf[3], qf[3], sb); };
    gload(a.t0); lstore(0); gload(a.t0 + 1 < a.t1 ? a.t0 + 1 : a.t0); lstore(1);
    __syncthreads();
    asm volatile("" : "+v"(qf[0]), "+v"(qf[1]), "+v"(qf[2]), "+v"(qf[3]));
    f32x16 s0a, s0b, s1a, s1b;
    qk(lds, 0, s0a, s0b);
    int slot = 0;
    for (int t = a.t0; t < a.t1; ++t) {
        const int slot1 = slot == 2 ? 0 : slot + 1, slot2 = slot1 == 2 ? 0 : slot1 + 1;
        { const int tn = t + 2; gload(tn < a.t1 ? tn : a.t1 - 1); }
        const unsigned char* Kb = lds + slot * AT_BUFB;
        qk(Kb, 1, s1a, s1b);
        const v8i v0 = rd32(Kb + voff), v1 = rd32(Kb + voff + 32 * A8_PITCH);
        v8i Pa, Pb;
        expsum(s0a, l0); expsum(s0b, l1); pack4(s0a, Pa, 0); pack4(s0b, Pb, 0);
        qk(lds + slot1 * AT_BUFB, 0, s0a, s0b);
        expsum(s1a, l0); expsum(s1b, l1); pack4(s1a, Pa, 4); pack4(s1b, Pb, 4);
        o0[0] = mfma8(v0, Pa, o0[0]); o1[0] = mfma8(v0, Pb, o1[0]); o0[1] = mfma8(v1, Pa, o0[1]); o1[1] = mfma8(v1, Pb, o1[1]);
        lstore(slot2);
        __syncthreads();
        slot = slot1;
    }
    float lt0 = l0[0] + l0[1] + l0[2] + l0[3]; lt0 += __shfl_xor(lt0, 32);
    float lt1 = l1[0] + l1[1] + l1[2] + l1[3]; lt1 += __shfl_xor(lt1, 32);
    bf16_t* op = a.out + (size_t)(wid * 32 + r) * 1024 + 4 * h;
    const float r0 = 16.0f / lt0, r1 = 16.0f * a.lam / lt1;
    float ss = 0.f;
#pragma unroll
    for (int d = 0; d < 2; ++d)
#pragma unroll
        for (int i = 0; i < 16; ++i) { const float v = o0[d][i] * r0 - o1[d][i] * r1; o0[d][i] = v; ss += v * v; }
    ss += __shfl_xor(ss, 32);
    const float rinv = rsqrtf(ss * (1.0f / 64.0f) + EPS) * a.oscale;
    f32x4 ggv[2][4];
#pragma unroll
    for (int d = 0; d < 2; ++d)
#pragma unroll
        for (int g = 0; g < 4; ++g) ggv[d][g] = *(const f32x4*)(a.subg + 32 * d + 8 * g + 4 * h);
    asm volatile("" : "+v"(ggv[0][0]), "+v"(ggv[1][3]));
#pragma unroll
    for (int d = 0; d < 2; ++d)
#pragma unroll
        for (int g = 0; g < 4; ++g) { const f32x4 gg = ggv[d][g];
            f32x4 v = {o0[d][4 * g] * rinv * gg[0], o0[d][4 * g + 1] * rinv * gg[1], o0[d][4 * g + 2] * rinv * gg[2], o0[d][4 * g + 3] * rinv * gg[3]}; store8(op + 32 * d + 8 * g, v); }
}

constexpr int FF_PITCH = 272;
constexpr int FF1_A = 0, FF1_B = 128 * FF_PITCH;
constexpr int FF3_A = 0, FF3_B = 64 * FF_PITCH;
DI void fft_load_a(unsigned char* lds, const bf16_t* M, int rows) {
    for (int idx = ld_tid(); idx < rows * 16; idx += 512) { const int r = idx >> 4, c = idx & 15; *(u32x4*)(lds + r * FF_PITCH + 16 * c) = *(const u32x4*)(M + r * 128 + 8 * c); }
    __syncthreads();
}
DI void fft1_unit(unsigned char* lds, const unsigned char* ws, int unit) {
    int tid = threadIdx.x; asm volatile("" : "+v"(tid));
    const int lane = tid & 63, r = lane & 31, h = lane >> 5, w = tid >> 6, b = unit >> 6, cq = unit & 63;
    const bf16_t* FT = (const bf16_t*)(ws + WS_FT) + (size_t)(b * 256 + 4 * cq) * 8192;
    unsigned char* Bt = lds + FF1_B;
    { u32x4 v[8];
#pragma unroll
      for (int j = 0; j < 8; ++j) { const int idx = tid + 512 * j, t2c = idx & 7, t1 = (idx >> 3) & 63, part = (idx >> 9) & 1, chl = idx >> 10;
          v[j] = *(const u32x4*)(FT + (size_t)chl * 8192 + part * 4096 + 64 * t1 + 8 * t2c); }
#pragma unroll
      for (int j = 0; j < 8; ++j) { const int idx = tid + 512 * j, t2c = idx & 7, t1 = (idx >> 3) & 63, part = (idx >> 9) & 1, chl = idx >> 10;
          unsigned char* d = Bt + (chl * 64 + 8 * t2c) * FF_PITCH + (part * 64 + t1) * 2;
#pragma unroll
          for (int e = 0; e < 4; ++e) { *(bf16_t*)(d + (2 * e) * FF_PITCH) = (bf16_t)(v[j][e] & 0xffffu); *(bf16_t*)(d + (2 * e + 1) * FF_PITCH) = (bf16_t)(v[j][e] >> 16); } } }
    __syncthreads();
    f32x16 acc[4];
#pragma unroll
    for (int rb = 0; rb < 4; ++rb) acc[rb] = (f32x16){};
#pragma unroll
    for (int ks = 0; ks < 8; ++ks) { const bf16x8 bf = *(const bf16x8*)(Bt + (32 * w + r) * FF_PITCH + 32 * ks + 16 * h);
#pragma unroll
        for (int rb = 0; rb < 4; ++rb) acc[rb] = mfma32(*(const bf16x8*)(lds + FF1_A + (32 * rb + r) * FF_PITCH + 32 * ks + 16 * h), bf, acc[rb]); }
    const int t2 = 32 * (w & 1) + r, ch = 4 * cq + (w >> 1);
    const float* TW = (const float*)(ws + WS_TW); bf16_t* Y2 = (bf16_t*)(const_cast<unsigned char*>(ws) + WS_Y2);
    f32x2 twv[2][16];
#pragma unroll
    for (int rb = 0; rb < 2; ++rb)
#pragma unroll
        for (int i = 0; i < 16; ++i) { const int k1 = 32 * rb + (i & 3) + 8 * (i >> 2) + 4 * h; twv[rb][i] = *(const f32x2*)(TW + 2 * (k1 * 64 + t2)); }
    asm volatile("" : "+v"(twv[0][0]), "+v"(twv[0][15]), "+v"(twv[1][0]), "+v"(twv[1][15]));
#pragma unroll
    for (int rb = 0; rb < 2; ++rb)
#pragma unroll
        for (int i = 0; i < 16; ++i) { const int k1 = 32 * rb + (i & 3) + 8 * (i >> 2) + 4 * h;
            const f32x2 tw = twv[rb][i]; const float re = acc[rb][i], im = acc[2 + rb][i];
            bf16_t* y = Y2 + ((size_t)((b * 64 + k1) * 256 + ch)) * 128 + t2;
            const unsigned pr = pk2(re * tw.x + im * tw.y, im * tw.x - re * tw.y);
            y[0] = (bf16_t)(pr & 0xffffu); y[64] = (bf16_t)(pr >> 16); }
    __syncthreads();
}
DI void fft3_unit(unsigned char* lds, const unsigned char* ws, int unit) {
    int tid = threadIdx.x; asm volatile("" : "+v"(tid));
    const int lane = tid & 63, r = lane & 31, h = lane >> 5, w = tid >> 6, b = unit >> 6, k1 = unit & 63;
    const bf16_t* Y2 = (const bf16_t*)(ws + WS_Y2) + (size_t)unit * 256 * 128;
    unsigned char* Bt = lds + FF3_B;
    { u32x4 v[8];
#pragma unroll
      for (int j = 0; j < 8; ++j) { const int idx = tid + 512 * j; v[j] = *(const u32x4*)(Y2 + (size_t)idx * 8); }
#pragma unroll
      for (int j = 0; j < 8; ++j) { const int idx = tid + 512 * j; *(u32x4*)(Bt + (idx >> 4) * FF_PITCH + 16 * (idx & 15)) = v[j]; } }
    __syncthreads();
    f32x16 acc[2];
    acc[0] = (f32x16){}; acc[1] = (f32x16){};
#pragma unroll
    for (int ks = 0; ks < 8; ++ks) { const bf16x8 bf = *(const bf16x8*)(Bt + (32 * w + r) * FF_PITCH + 32 * ks + 16 * h);
#pragma unroll
        for (int rb = 0; rb < 2; ++rb) acc[rb] = mfma32(*(const bf16x8*)(lds + FF3_A + (32 * rb + r) * FF_PITCH + 32 * ks + 16 * h), bf, acc[rb]); }
    bf16_t* CAT = (bf16_t*)(const_cast<unsigned char*>(ws) + WS_CAT) + (size_t)(b * SEQ + k1) * 1024 + 512 + 32 * w + r;
#pragma unroll
    for (int rb = 0; rb < 2; ++rb)
#pragma unroll
        for (int i = 0; i < 16; ++i) { const int k2 = 32 * rb + (i & 3) + 8 * (i >> 2) + 4 * h; CAT[(size_t)k2 * 64 * 1024] = (bf16_t)(pk2(acc[rb][i], 0.f) & 0xffffu); }
    __syncthreads();
}

DI void load_row(const float* xr, int lane, f32x4 (&v)[4]) {
    v[0] = *(const f32x4*)(xr + 8 * lane); v[1] = *(const f32x4*)(xr + 8 * lane + 4); v[2] = *(const f32x4*)(xr + 512 + 8 * lane); v[3] = *(const f32x4*)(xr + 512 + 8 * lane + 4);
}
DI void load_row_bf(const bf16_t* xr, int lane, f32x4 (&v)[4]) {
    const u32x4 a = *(const u32x4*)(xr + 8 * lane), b = *(const u32x4*)(xr + 512 + 8 * lane);
    v[0] = (f32x4){bflo(a[0]), bfhi(a[0]), bflo(a[1]), bfhi(a[1])}; v[1] = (f32x4){bflo(a[2]), bfhi(a[2]), bflo(a[3]), bfhi(a[3])};
    v[2] = (f32x4){bflo(b[0]), bfhi(b[0]), bflo(b[1]), bfhi(b[1])}; v[3] = (f32x4){bflo(b[2]), bfhi(b[2]), bflo(b[3]), bfhi(b[3])};
}
DI void modnorm_row(f32x4 (&v)[4], int lane, const float* g, const float* sh, const float* sc) {
    float ss = 0.f;
#pragma unroll
    for (int j = 0; j < 4; ++j)
#pragma unroll
        for (int i = 0; i < 4; ++i) ss += v[j][i] * v[j][i];
    ss = wave_sum(ss);
    const float rinv = rsqrtf(ss * (1.0f / 1024.0f) + EPS);
#pragma unroll
    for (int j = 0; j < 4; ++j) { const int k = (j >> 1) * 512 + 8 * lane + 4 * (j & 1);
        const f32x4 gg = *(const f32x4*)(g + k), s1 = *(const f32x4*)(sc + k), s0 = *(const f32x4*)(sh + k);
        v[j] = v[j] * rinv * gg * (s1 + 1.0f) + s0; }
}
DI void store_row_bf16(bf16_t* hr, int lane, const f32x4 (&v)[4]) { store16(hr + 8 * lane, v[0], v[1]); store16(hr + 512 + 8 * lane, v[2], v[3]); }

DI void phase_norm1(const Params& P, bf16_t* H, const float* mod0, int G) {
    const int tid_ = ld_tid(); const int lane = tid_ & 63, gw = blockIdx.x * 8 + (tid_ >> 6);
    for (int row = gw; row < NTOK; row += G * 8) {
        const float* xr = row < NLAT ? P.x + (size_t)row * 1024 : P.ctx + (size_t)(row - NLAT) * 1024;
        const float* md = mod0 + (row < NLAT ? (row >> 12) : 8) * 6144;
        f32x4 v[4]; load_row(xr, lane, v);
        modnorm_row(v, lane, P.norm1_g, md, md + 1024);
        store_row_bf16(H + (size_t)row * 1024, lane, v);
    }
}

DI void conv_unit(unsigned char* lds, int seqrow, int L, int t0, const bf16_t* BU, const bf16_t* BG, const float* cw, const float* cb, const float* lg, const float* lb, bf16_t* CAT) {
    float* z = (float*)lds;
    int tid = threadIdx.x; asm volatile("" : "+v"(tid));
    { u32x4 uv[6], gv[6];
#pragma unroll
      for (int q = 0; q < 6; ++q) { const int idx = tid + 512 * q, j = idx >> 5, c8 = (idx & 31) * 8, t = t0 - 15 + j; const bool ok = idx < 94 * 32 && t >= 0 && t < L;
          const size_t off = (size_t)(seqrow + (ok ? t : t0)) * 256 + c8; uv[q] = *(const u32x4*)(BU + off); gv[q] = *(const u32x4*)(BG + off); }
#pragma unroll
      for (int q = 0; q < 6; ++q) { const int idx = tid + 512 * q, j = idx >> 5, c8 = (idx & 31) * 8, t = t0 - 15 + j;
          if (idx < 94 * 32) { const bool ok = t >= 0 && t < L; float o[8];
#pragma unroll
              for (int e = 0; e < 4; ++e) { o[2 * e] = ok ? bflo(uv[q][e]) * sigmoidf_(bflo(gv[q][e])) : 0.f; o[2 * e + 1] = ok ? bfhi(uv[q][e]) * sigmoidf_(bfhi(gv[q][e])) : 0.f; }
              *(f32x4*)(z + j * 256 + c8) = (f32x4){o[0], o[1], o[2], o[3]}; *(f32x4*)(z + j * 256 + c8 + 4) = (f32x4){o[4], o[5], o[6], o[7]}; } } }
    __syncthreads();
    const int c = tid & 255, half = tid >> 8;
    float acc[32];
    { const float b = cb[c];
#pragma unroll
      for (int i = 0; i < 32; ++i) acc[i] = b; }
    { float wj[31], zr[62];
#pragma unroll
      for (int j = 0; j < 31; ++j) wj[j] = cw[j * 256 + c];
#pragma unroll
      for (int q = 0; q < 62; ++q) zr[q] = z[(32 * half + q) * 256 + c];
#pragma unroll
      for (int j = 0; j < 31; ++j)
#pragma unroll
          for (int i = 0; i < 32; ++i) acc[i] += wj[j] * zr[i + j]; }
    __syncthreads();
#pragma unroll
    for (int i = 0; i < 32; ++i) z[(32 * half + i) * 256 + c] = acc[i];
    __syncthreads();
    const int lane = tid & 63, wv = tid >> 6;
    const f32x4 g4 = *(const f32x4*)(lg + 4 * lane), b4 = *(const f32x4*)(lb + 4 * lane);
    for (int tt = wv; tt < 64; tt += 8) {
        const f32x4 v = *(const f32x4*)(z + tt * 256 + 4 * lane);
        const float mean = wave_sum(v[0] + v[1] + v[2] + v[3]) * (1.0f / 256.0f);
        const f32x4 d = v - mean;
        const float var = wave_sum(d[0] * d[0] + d[1] * d[1] + d[2] * d[2] + d[3] * d[3]) * (1.0f / 256.0f);
        const f32x4 y = d * rsqrtf(var + EPS) * g4 + b4;
        f32x4 o;
#pragma unroll
        for (int e = 0; e < 4; ++e) o[e] = y[e] * sigmoidf_(y[e]);
        store8(CAT + (size_t)(seqrow + t0 + tt) * 1024 + 256 + 4 * lane, o);
    }
    __syncthreads();
}

constexpr int RT_CH = 136;
constexpr int RT_HS = 0, RT_PART = 16 * 1028 * 4, RT_LOG = RT_PART + 8 * 16 * 32 * 4, RT_HIST = RT_LOG + 144 * 33 * 4, RT_BASE = RT_HIST + 128, RT_RE = RT_BASE + 128, RT_RP = RT_RE + RT_CH * 16, RT_RG = RT_RP + RT_CH * 16;
DI void phase_router(unsigned char* lds, const Params& P, int li, const bf16_t* X1, unsigned char* H8, const float* modl, unsigned* cnt, int* tok_e, int* tok_pos, float* tok_gate, int* tok_list, int G, int ntok, int chsz) {
    const int tid = ld_tid(), lane = tid & 63, w = tid >> 6;
    float* Hs = (float*)(lds + RT_HS); float* part = (float*)(lds + RT_PART); float* logit = (float*)(lds + RT_LOG);
    int* hist = (int*)(lds + RT_HIST); int* base = (int*)(lds + RT_BASE); int* rec_e = (int*)(lds + RT_RE); int* rec_p = (int*)(lds + RT_RP); float* rec_g = (float*)(lds + RT_RG);
    const float* rw = P.router_w + (size_t)li * 1024 * 32; const float* rb = P.router_b + li * 32; const float* g2n = P.norm2_g + li * 1024;
    float wreg[32][2];
#pragma unroll
    for (int s = 0; s < 32; ++s)
#pragma unroll
        for (int hf = 0; hf < 2; ++hf) wreg[s][hf] = rw[(size_t)(128 * w + 4 * s + (lane >> 4)) * 32 + 16 * hf + (lane & 15)];
    f32x4 ma[4], mb[4]; int cur_b9 = -1;
    auto load_mod = [&](int b9) __attribute__((always_inline)) { const float* md = modl + b9 * 6144;
#pragma unroll
        for (int j = 0; j < 4; ++j) { const int k = (j >> 1) * 512 + 8 * lane + 4 * (j & 1); ma[j] = *(const f32x4*)(g2n + k) * (*(const f32x4*)(md + 4 * 1024 + k) + 1.0f); mb[j] = *(const f32x4*)(md + 3 * 1024 + k); }
        cur_b9 = b9; };
    for (int ch = blockIdx.x; ch * chsz < ntok; ch += G) {
        const int c0 = ch * chsz, ngrp = (chsz + 15) / 16;
        if (tid < 32) hist[tid] = 0;
        u32x4 ra[2], rbv[2];
        auto fetch = [&](int g) __attribute__((always_inline)) {
#pragma unroll
            for (int rr = 0; rr < 2; ++rr) { const int tl = 16 * g + 2 * w + rr; const bf16_t* xr = X1 + (size_t)(c0 + (tl < chsz ? tl : 0)) * 1024;
                ra[rr] = *(const u32x4*)(xr + 8 * lane); rbv[rr] = *(const u32x4*)(xr + 512 + 8 * lane); } };
        fetch(0);
        __syncthreads();
        for (int g = 0; g < ngrp; ++g) {
#pragma unroll
            for (int rr = 0; rr < 2; ++rr) {
                const int tl = 16 * g + 2 * w + rr, tok = c0 + tl; float* hs = Hs + (2 * w + rr) * 1028;
                f32x4 v[4];
                if (tl < chsz) {
                    const u32x4 a = ra[rr], b = rbv[rr];
                    v[0] = (f32x4){bflo(a[0]), bfhi(a[0]), bflo(a[1]), bfhi(a[1])}; v[1] = (f32x4){bflo(a[2]), bfhi(a[2]), bflo(a[3]), bfhi(a[3])};
                    v[2] = (f32x4){bflo(b[0]), bfhi(b[0]), bflo(b[1]), bfhi(b[1])}; v[3] = (f32x4){bflo(b[2]), bfhi(b[2]), bflo(b[3]), bfhi(b[3])};
                    const int b9 = tok < NLAT ? (tok >> 12) : 8; if (b9 != cur_b9) load_mod(b9);
                    float ss = 0.f;
#pragma unroll
                    for (int j = 0; j < 4; ++j)
#pragma unroll
                        for (int i = 0; i < 4; ++i) ss += v[j][i] * v[j][i];
                    ss = wave_sum(ss);
                    const float rinv = __builtin_amdgcn_rsqf(ss * (1.0f / 1024.0f) + EPS);
#pragma unroll
                    for (int j = 0; j < 4; ++j) v[j] = v[j] * rinv * ma[j] + mb[j];
                    { unsigned char* hr = H8 + (size_t)tok * 1024; u32x2 w0, w1;
                      w0.x = pk4_fp8(clamp448(v[0][0]), clamp448(v[0][1]), clamp448(v[0][2]), clamp448(v[0][3])); w0.y = pk4_fp8(clamp448(v[1][0]), clamp448(v[1][1]), clamp448(v[1][2]), clamp448(v[1][3]));
                      w1.x = pk4_fp8(clamp448(v[2][0]), clamp448(v[2][1]), clamp448(v[2][2]), clamp448(v[2][3])); w1.y = pk4_fp8(clamp448(v[3][0]), clamp448(v[3][1]), clamp448(v[3][2]), clamp448(v[3][3]));
                      *(u32x2*)(hr + 8 * lane) = w0; *(u32x2*)(hr + 512 + 8 * lane) = w1; } }
                else {
#pragma unroll
                    for (int j = 0; j < 4; ++j) v[j] = (f32x4){0.f, 0.f, 0.f, 0.f}; }
                *(f32x4*)(hs + 8 * lane) = v[0]; *(f32x4*)(hs + 8 * lane + 4) = v[1]; *(f32x4*)(hs + 512 + 8 * lane) = v[2]; *(f32x4*)(hs + 512 + 8 * lane + 4) = v[3];
            }
            if (g + 1 < ngrp) fetch(g + 1);
            __syncthreads();
            f32x4 a0 = {0.f, 0.f, 0.f, 0.f}, a1 = {0.f, 0.f, 0.f, 0.f};
            { const float* hp = Hs + (lane & 15) * 1028 + 128 * w + (lane >> 4);
#pragma unroll
              for (int s = 0; s < 32; ++s) { const float av = hp[4 * s];
                  a0 = __builtin_amdgcn_mfma_f32_16x16x4f32(av, wreg[s][0], a0, 0, 0, 0); a1 = __builtin_amdgcn_mfma_f32_16x16x4f32(av, wreg[s][1], a1, 0, 0, 0); } }
#pragma unroll
            for (int i = 0; i < 4; ++i) { part[(w * 16 + 4 * (lane >> 4) + i) * 32 + (lane & 15)] = a0[i]; part[(w * 16 + 4 * (lane >> 4) + i) * 32 + 16 + (lane & 15)] = a1[i]; }
            __syncthreads();
            { const int tk = tid >> 5, e = tid & 31; float s = rb[e];
#pragma unroll
              for (int ww = 0; ww < 8; ++ww) s += part[(ww * 16 + tk) * 32 + e];
              logit[(16 * g + tk) * 33 + e] = s; }
        }
        __syncthreads();
        if (tid < chsz) {
            float v0 = -INFINITY, v1 = -INFINITY, v2 = -INFINITY, v3 = -INFINITY; int e0 = 0, e1 = 0, e2 = 0, e3 = 0;
            for (int e = 0; e < 32; ++e) { const float x = logit[tid * 33 + e];
                if (x > v0) { v3 = v2; e3 = e2; v2 = v1; e2 = e1; v1 = v0; e1 = e0; v0 = x; e0 = e; }
                else if (x > v1) { v3 = v2; e3 = e2; v2 = v1; e2 = e1; v1 = x; e1 = e; }
                else if (x > v2) { v3 = v2; e3 = e2; v2 = x; e2 = e; }
                else if (x > v3) { v3 = x; e3 = e; } }
            const float p1 = __expf(v1 - v0), p2 = __expf(v2 - v0), p3 = __expf(v3 - v0), inv = 1.0f / (1.0f + p1 + p2 + p3);
            const int tl = tid;
            rec_e[tl * 4 + 0] = e0; rec_e[tl * 4 + 1] = e1; rec_e[tl * 4 + 2] = e2; rec_e[tl * 4 + 3] = e3;
            rec_g[tl * 4 + 0] = inv; rec_g[tl * 4 + 1] = p1 * inv; rec_g[tl * 4 + 2] = p2 * inv; rec_g[tl * 4 + 3] = p3 * inv;
            rec_p[tl * 4 + 0] = atomicAdd(&hist[e0], 1); rec_p[tl * 4 + 1] = atomicAdd(&hist[e1], 1); rec_p[tl * 4 + 2] = atomicAdd(&hist[e2], 1); rec_p[tl * 4 + 3] = atomicAdd(&hist[e3], 1);
        }
        __syncthreads();
        if (tid < 32) base[tid] = (int)__hip_atomic_fetch_add(cnt + tid, (unsigned)hist[tid], __ATOMIC_RELAXED, __HIP_MEMORY_SCOPE_AGENT);
        __syncthreads();
        for (int idx = tid; idx < chsz * 4; idx += 512) { const int e = rec_e[idx], pos = base[e] + rec_p[idx]; tok_e[c0 * 4 + idx] = e; tok_pos[c0 * 4 + idx] = pos; tok_gate[c0 * 4 + idx] = rec_g[idx];
            tok_list[e * NTOK + pos] = c0 + (idx >> 2); }
        __syncthreads();
    }
}

DI void moe_tables(LAS int* tab, const unsigned* cnt) {
    const int tid = ld_tid();
    if (tid < 64) {
        const int e = tid & 31;
        const int n = tid < 32 ? ((int)__hip_atomic_load(cnt + e, __ATOMIC_RELAXED, __HIP_MEMORY_SCOPE_AGENT) + 255) >> 8 : 0;
        int incl = n;
#pragma unroll
        for (int o = 1; o < 32; o <<= 1) { const int v = __shfl_up(incl, o); if (tid >= o) incl += v; }
        const int excl = incl - n;
        if (tid < 32) { tab[32 + e] = excl * 256;
#pragma nounroll
            for (int j = 0; j < n; ++j) if (excl + j < MAXMT) tab[64 + excl + j] = e;
            if (tid == 31) tab[0] = incl < MAXMT ? incl : MAXMT; }
    }
    __syncthreads();
}
DI void phase_scatter(const LAS int* tab, const unsigned char* H8, unsigned char* XP, const int* tok_e, const int* tok_pos, int* tok_slot, int G, int ntok) {
    const int tid_ = ld_tid(); const int lane = tid_ & 63, gw = blockIdx.x * 8 + (tid_ >> 6);
    for (int tok = gw; tok < ntok; tok += G * 8) {
        int slot = 0;
        if (lane < 4) { slot = tab[32 + tok_e[tok * 4 + lane]] + tok_pos[tok * 4 + lane]; tok_slot[tok * 4 + lane] = slot; }
        const u32x4 a = *(const u32x4*)(H8 + (size_t)tok * 1024 + 16 * lane);
#pragma unroll
        for (int k = 0; k < 4; ++k) { const int s = __shfl(slot, k); *(u32x4*)(XP + (size_t)s * 1024 + 16 * lane) = a; }
    }
}
DI void phase_combine(const Params& P, int li, const bf16_t* X1, bf16_t* X2, const unsigned char* YB, const LAS int* tab, const int* tok_e, const int* tok_pos, const float* tok_gate, const float* modl, const float* modn, bf16_t* H, int G) {
    const int tid_ = ld_tid(); const int lane = tid_ & 63, gw = blockIdx.x * 8 + (tid_ >> 6);
    const bool last = (li == DEPTH - 1);
    const int N = last ? NLAT : NTOK, S = G * 8;
    int sl[2][4]; float gt[2][4];
    auto ldidx = [&](int tA, int (&s_)[2][4], float (&g_)[2][4]) __attribute__((always_inline)) {
#pragma unroll
        for (int q = 0; q < 2; ++q) { int t = tA + q * S; t = t < N ? t : gw;
            const v4i e4 = *(const v4i*)(tok_e + t * 4), p4 = *(const v4i*)(tok_pos + t * 4); const f32x4 g4 = *(const f32x4*)(tok_gate + t * 4);
#pragma unroll
            for (int k = 0; k < 4; ++k) { s_[q][k] = tab[32 + e4[k]] + p4[k]; g_[q][k] = g4[k]; } } };
    if (gw < N) ldidx(gw, sl, gt);
    for (int tok = gw; tok < N; tok += 2 * S) {
        u32x4 xa[2][2]; u32x2 ya[2][4][2];
#pragma unroll
        for (int q = 0; q < 2; ++q) { int t = tok + q * S; t = t < N ? t : tok;
            xa[q][0] = *(const u32x4*)(X1 + (size_t)t * 1024 + 8 * lane); xa[q][1] = *(const u32x4*)(X1 + (size_t)t * 1024 + 512 + 8 * lane);
#pragma unroll
            for (int k = 0; k < 4; ++k) { ya[q][k][0] = *(const u32x2*)(YB + (size_t)sl[q][k] * 1024 + 8 * lane); ya[q][k][1] = *(const u32x2*)(YB + (size_t)sl[q][k] * 1024 + 512 + 8 * lane); } }
        float gc[2][4];
#pragma unroll
        for (int q = 0; q < 2; ++q)
#pragma unroll
            for (int k = 0; k < 4; ++k) gc[q][k] = gt[q][k];
        { const int nt = tok + 2 * S; ldidx(nt < N ? nt : gw, sl, gt); }
#pragma unroll
        for (int q = 0; q < 2; ++q) { const int t = tok + q * S;
            if (t < N) {
                const int b9 = t < NLAT ? (t >> 12) : 8;
                f32x4 v[4];
                { const u32x4 a = xa[q][0], b = xa[q][1];
                  v[0] = (f32x4){bflo(a[0]), bfhi(a[0]), bflo(a[1]), bfhi(a[1])}; v[1] = (f32x4){bflo(a[2]), bfhi(a[2]), bflo(a[3]), bfhi(a[3])};
                  v[2] = (f32x4){bflo(b[0]), bfhi(b[0]), bflo(b[1]), bfhi(b[1])}; v[3] = (f32x4){bflo(b[2]), bfhi(b[2]), bflo(b[3]), bfhi(b[3])}; }
                f32x4 y[4];
#pragma unroll
                for (int j = 0; j < 4; ++j) y[j] = (f32x4){0.f, 0.f, 0.f, 0.f};
#pragma unroll
                for (int k = 0; k < 4; ++k) { const float g = gc[q][k]; const u32x2 a = ya[q][k][0], b = ya[q][k][1];
                    { const f32x2 p0 = __builtin_amdgcn_cvt_pk_f32_fp8((int)a.x, false), p1 = __builtin_amdgcn_cvt_pk_f32_fp8((int)a.x, true), p2 = __builtin_amdgcn_cvt_pk_f32_fp8((int)a.y, false), p3 = __builtin_amdgcn_cvt_pk_f32_fp8((int)a.y, true);
                      y[0] += g * (f32x4){p0.x, p0.y, p1.x, p1.y}; y[1] += g * (f32x4){p2.x, p2.y, p3.x, p3.y}; }
                    { const f32x2 p0 = __builtin_amdgcn_cvt_pk_f32_fp8((int)b.x, false), p1 = __builtin_amdgcn_cvt_pk_f32_fp8((int)b.x, true), p2 = __builtin_amdgcn_cvt_pk_f32_fp8((int)b.y, false), p3 = __builtin_amdgcn_cvt_pk_f32_fp8((int)b.y, true);
                      y[2] += g * (f32x4){p0.x, p0.y, p1.x, p1.y}; y[3] += g * (f32x4){p2.x, p2.y, p3.x, p3.y}; } }
                const float* g2 = modl + b9 * 6144 + 5 * 1024;
#pragma unroll
                for (int j = 0; j < 4; ++j) { const int k = (j >> 1) * 512 + 8 * lane + 4 * (j & 1); v[j] += *(const f32x4*)(g2 + k) * y[j]; }
                if (last) { float* o = P.out + (size_t)t * 1024; *(f32x4*)(o + 8 * lane) = v[0]; *(f32x4*)(o + 8 * lane + 4) = v[1]; *(f32x4*)(o + 512 + 8 * lane) = v[2]; *(f32x4*)(o + 512 + 8 * lane + 4) = v[3]; }
                else { store_row_bf16(X2 + (size_t)t * 1024, lane, v);
                    const float* md = modn + b9 * 6144;
                    modnorm_row(v, lane, P.norm1_g + (li + 1) * 1024, md, md + 1024);
                    store_row_bf16(H + (size_t)t * 1024, lane, v); }
            } }
    }
}

DI int invperm32(int c) { return 16 * ((c >> 2) & 1) + 4 * (c >> 3) + (c & 3); }
DI int fwd_win(int n) {
    if (n < 256) { const int hd = n >> 6, d = n & 63; return (d >> 5) * 128 + hd * 32 + (d & 31); }
    if (n < 384) { const int m = n - 256, hd = m >> 6, d = m & 63; return 256 + (d >> 5) * 128 + hd * 32 + (d & 31); }
    if (n < 512) { const int m = n - 384, kvh = m >> 6, d = m & 63; return 256 + 128 * (d >> 5) + 32 * (2 + kvh) + invperm32(d & 31); }
    if (n < 1024) { const int m = n - 512; return 512 + (m & ~31) + invperm32(m & 31); }
    if (n < 1280) return -1;
    if (n < 1792) { const int m = n - 1280, T = m >> 8, r = m & 255, hd = r >> 6, c = (r >> 5) & 1, dim = r & 31;
        const int nn = (dim >> 3) & 1, fq = 2 * (dim >> 4) + ((dim >> 2) & 1), i = dim & 3; return 1024 + T * 256 + c * 128 + hd * 32 + 16 * nn + 4 * fq + i; }
    return 4096 + (n - 1792);
}
DI int fwd_gu(int n) { const int bj = n >> 10, r = n & 1023, T = r >> 7, rr = r & 127; return T * 256 + bj * 128 + (rr & ~31) + invperm32(rr & 31); }
DI int fwd_lane16(int c) { const int pn = c >> 8, r = c & 255, wc = r >> 6, fq = (r >> 4) & 3, bj = (r >> 3) & 1, nn = (r >> 2) & 1, i = r & 3; return pn * 256 + bj * 128 + wc * 32 + nn * 16 + fq * 4 + i; }
DI int fwd_dn(int n) { return fwd_lane16(n); }
constexpr int PREP_T_IN = 32 * 8, PREP_T_OUT = 16 * 8, PREP_T_GU = NE * 32 * 8, PREP_T_DN = NE * 16 * 8, PREP_TILES_L = PREP_T_IN + PREP_T_OUT + PREP_T_GU + PREP_T_DN, PREP_TILES_S = PREP_T_IN + PREP_T_OUT;
DI void phase_prep(unsigned char* lds, const Params& P, int G) {
    const int tid = ld_tid(), blk = blockIdx.x;
    unsigned char* ws = P.ws;
    float* lc = (float*)lds; float* ls = lc + 4096;
    for (int j = tid; j < 4096; j += 512) { float s, c; sincospif((float)j * (1.0f / 2048.0f), &s, &c); lc[j] = c; ls[j] = s; }
    __syncthreads();
    {
      if (blk == 0) { bf16_t* M1 = (bf16_t*)(ws + WS_M1);
          for (int idx = tid; idx < 128 * 128; idx += 512) { const int row = idx >> 7, k = idx & 127, ri = row >> 6, k1 = row & 63, part = k >> 6, t1 = k & 63; const int j = ((k1 * t1) & 63) * 64;
              const float c = lc[j], sn = ls[j]; M1[idx] = (bf16_t)(pk2(ri == 0 ? (part == 0 ? c : -sn) : (part == 0 ? -sn : -c), 0.f) & 0xffffu); } }
      if (blk == 1 % G) { bf16_t* M3 = (bf16_t*)(ws + WS_M3);
          for (int idx = tid; idx < 64 * 128; idx += 512) { const int k2 = idx >> 7, k = idx & 127, part = k >> 6, t2 = k & 63; const int j = ((k2 * t2) & 63) * 64;
              M3[idx] = (bf16_t)(pk2((part == 0 ? lc[j] : ls[j]) * (1.0f / 64.0f), 0.f) & 0xffffu); } }
      if (blk == 2 % G) { float* TW = (float*)(ws + WS_TW);
          for (int idx = tid; idx < 64 * 64; idx += 512) { const int k1 = idx >> 6, t2 = idx & 63; const int j = (k1 * t2) & 4095; TW[2 * idx] = lc[j]; TW[2 * idx + 1] = ls[j]; } }
      bf16_t* TC = (bf16_t*)(ws + WS_TC);
      for (int k = blk; k < 256; k += G)
          for (int chunk = tid; chunk < 64; chunk += 512) { const int part = chunk >> 5, t0 = (chunk & 31) * 8; float v[8];
#pragma unroll
              for (int e = 0; e < 8; ++e) { const int j = ((k * (t0 + e)) & 255) * 16; v[e] = (part ? -ls[j] : lc[j]) * (1.0f / 16.0f); }
              store16(TC + (size_t)k * 512 + part * 256 + t0, (f32x4){v[0], v[1], v[2], v[3]}, (f32x4){v[4], v[5], v[6], v[7]}); } }
    { float* wv = (float*)(lds + 32768);
      for (int u = blk; u < DEPTH * 64; u += G) { const int li = u >> 6, k0 = (u & 63) * 16;
          for (int idx = tid; idx < 16 * 64; idx += 512) { const int row = idx >> 6, c4 = (idx & 63) * 4;
              *(f32x4*)(wv + row * 256 + c4) = *(const f32x4*)(P.w_in + ((size_t)li * 1024 + k0 + row) * 2048 + 1024 + c4); }
          __syncthreads();
          const int ch = tid & 255, part = tid >> 8, g = ch >> 6, cp = ch & 63;
          float acc[16];
#pragma unroll
          for (int kk = 0; kk < 16; ++kk) acc[kk] = 0.f;
          const float* tw = part ? ls : lc;
          for (int c = 0; c < 64; ++c) { const float t = tw[((c * cp) & 63) * 64];
#pragma unroll
              for (int kk = 0; kk < 16; ++kk) acc[kk] += wv[kk * 256 + 64 * g + c] * t; }
          bf16_t* d = (bf16_t*)(ws + WS_WCH + (size_t)li * SZ_WCH) + (size_t)(256 + 256 * part + ch) * 1024 + k0;
          store16(d, (f32x4){acc[0], acc[1], acc[2], acc[3]} * 0.125f, (f32x4){acc[4], acc[5], acc[6], acc[7]} * 0.125f);
          store16(d + 8, (f32x4){acc[8], acc[9], acc[10], acc[11]} * 0.125f, (f32x4){acc[12], acc[13], acc[14], acc[15]} * 0.125f);
          __syncthreads(); } }
    { unsigned* tl = (unsigned*)(lds + 32768);
      const int n4 = (tid & 15) * 4, kp = tid >> 4;
      auto decode = [&](int t, const float*& src, int& ld, int& type, int& n0, int& k0, int& li) __attribute__((always_inline)) {
          li = t / PREP_TILES_S; int u = t % PREP_TILES_S;
          if (u < PREP_T_IN) { src = P.w_in + (size_t)li * 1024 * 2048; ld = 2048; type = 0; }
          else { u -= PREP_T_IN; src = P.w_out + (size_t)li * 1024 * 1024; ld = 1024; type = 2; }
          const int nnt = ld >> 6; n0 = (u % nnt) * 64; k0 = (u / nnt) * 128; };
      f32x4 ra[4], rb[4], rc[4];
      auto issue = [&](int t, f32x4 (&r)[4]) __attribute__((always_inline)) { const float* src; int ld, type, n0, k0, li; decode(t, src, ld, type, n0, k0, li);
          const float* p = src + (size_t)(k0 + 2 * kp) * ld + n0 + n4;
          r[0] = *(const f32x4*)p; r[1] = *(const f32x4*)(p + ld); r[2] = *(const f32x4*)(p + (size_t)64 * ld); r[3] = *(const f32x4*)(p + (size_t)65 * ld); };
      int par = 0;
      auto proc = [&](int t, const f32x4 (&cur)[4]) __attribute__((always_inline)) {
          const float* src; int ld, type, n0, k0, li; decode(t, src, ld, type, n0, k0, li);
          unsigned* tlp = tl + par * (64 * 68); par ^= 1;
#pragma unroll
          for (int j = 0; j < 4; ++j) { tlp[(n4 + j) * 68 + kp] = pk2(cur[0][j], cur[1][j]); tlp[(n4 + j) * 68 + 32 + kp] = pk2(cur[2][j], cur[3][j]); }
          __syncthreads();
          const int nl = tid >> 3, c8 = tid & 7, n = n0 + nl;
          int p = type == 0 ? fwd_win(n) : fwd_lane16(n);
          size_t base = type == 0 ? WS_WTOK + (size_t)li * SZ_WTOK : WS_WOUT + (size_t)li * SZ_WOUT;
          if (p >= 4096) { p -= 4096; base = WS_WCH + (size_t)li * SZ_WCH; }
          bf16_t* d = (bf16_t*)(ws + base);
          if (p >= 0) { const u32x4 a = *(const u32x4*)(tlp + nl * 68 + 4 * c8), b = *(const u32x4*)(tlp + nl * 68 + 32 + 4 * c8);
              *(u32x4*)(d + (size_t)p * 1024 + k0 + 8 * c8) = a; *(u32x4*)(d + (size_t)p * 1024 + k0 + 64 + 8 * c8) = b; } };
      constexpr int NTILES = DEPTH * PREP_TILES_S;
      int t = blk;
      if (t < NTILES) issue(t, ra);
      if (t + G < NTILES) issue(t + G, rb);
      while (t < NTILES) {
          if (t + 2 * G < NTILES) issue(t + 2 * G, rc);
          proc(t, ra); t += G; if (t >= NTILES) break;
          if (t + 2 * G < NTILES) issue(t + 2 * G, ra);
          proc(t, rb); t += G; if (t >= NTILES) break;
          if (t + 2 * G < NTILES) issue(t + 2 * G, rb);
          proc(t, rc); t += G;
      }
      __syncthreads();
    }
    { float* sc = (float*)(lds + 32768); float* red = sc + 9216;
      for (int mb = blk; mb < DEPTH * 128; mb += G) { const int li = mb >> 7, cb = mb & 127;
          for (int idx = tid; idx < 9216; idx += 512) { const int r = idx >> 10, k = idx & 1023; const float v = r < 8 ? P.c[r * 1024 + k] : P.c_ctx[k]; sc[idx] = v * sigmoidf_(v); }
          __syncthreads();
          if (tid < 384) { const int cg = tid % 12, ks = tid / 12;
              f32x4 acc[9];
#pragma unroll
              for (int r = 0; r < 9; ++r) acc[r] = (f32x4){0.f, 0.f, 0.f, 0.f};
              for (int k0 = 32 * ks; k0 < 32 * ks + 32; k0 += 8) {
                  f32x4 w4[8];
#pragma unroll
                  for (int j = 0; j < 8; ++j) w4[j] = *(const f32x4*)(P.ada_w + ((size_t)li * 1024 + k0 + j) * 6144 + 48 * cb + 4 * cg);
#pragma unroll
                  for (int j = 0; j < 8; ++j)
#pragma unroll
                      for (int r = 0; r < 9; ++r) acc[r] += sc[r * 1024 + k0 + j] * w4[j]; }
#pragma unroll
              for (int r = 0; r < 9; ++r) *(f32x4*)(red + ks * 432 + (r * 12 + cg) * 4) = acc[r]; }
          __syncthreads();
          if (tid < 432) { const int r = tid / 48, cc = tid % 48; float s = P.ada_b[li * 6144 + 48 * cb + cc];
              for (int ks = 0; ks < 32; ++ks) s += red[ks * 432 + tid];
              ((float*)(ws + WS_MOD))[(size_t)(li * 9 + r) * 6144 + 48 * cb + cc] = s; }
          __syncthreads(); } }
    if (blk == G - 1) { float* rp = (float*)(ws + WS_ROPE);
        for (int idx = tid; idx < 1024; idx += 512) { const int pos = idx >> 4, f = idx & 15; const double ang = (double)pos * pow(10000.0, -(double)f / 16.0); rp[idx] = (float)cos(ang); rp[1024 + idx] = (float)sin(ang); }
        for (int idx = tid; idx < 512; idx += 512) { const int pos = idx >> 3, f = idx & 7; const double ang = (double)pos * pow(10000.0, -(double)f / 8.0); rp[2048 + idx] = (float)cos(ang); rp[2560 + idx] = (float)sin(ang); } }
}

constexpr int NPHASE = 2 + 8 * DEPTH;
#ifndef PHMASK
#define PHMASK 0xFFFFFFFFu
#endif
#ifndef SUBMASK
#define SUBMASK 0xFFu
#endif
#define SUBEN(j) ((SUBMASK >> (j)) & 1u)
#define PHEN(k) ((PHMASK >> ((k) < 2 ? (k) : 2 + (((k) - 2) & 7))) & 1u)

#define IN(k) (PHEN(k) && lo <= (k) && (k) < hi)
#define SEAM(k) do { if (IN(k) && IN((k) + 1)) { KParamsPtr kq = kparams(); XcdBarrier bar; bar.bar = (unsigned*)(kq->ws + WS_BAR); bar.x = xb_xcc_id(); bar.st = (volatile LAS unsigned*)(ldsL + LDS_BARW); xcd_barrier(bar); } } while (0)
#define WSP(T, off) ((T*)(ws + (off)))
#ifndef REPMASK
#define REPMASK 0u
#endif
#ifndef SUBREP
#define SUBREP 0u
#endif
#ifndef REP_N
#define REP_N 1
#endif
#define NREP(j) ((((REPMASK) >> (j)) & 1u) ? (1 + REP_N) : 1)
#define NSUB(x) ((((SUBREP) >> (x)) & 1u) ? (1 + REP_N) : 1)
#define FORCEBAR() do { KParamsPtr kq = kparams(); XcdBarrier bar; bar.bar = (unsigned*)(kq->ws + WS_BAR); bar.x = xb_xcc_id(); bar.st = (volatile LAS unsigned*)(ldsL + LDS_BARW); xcd_barrier(bar); } while (0)
#define REPBEG(j) for (int rep_ = 0; rep_ < NREP(j); ++rep_) {
#define REPEND(j) if (rep_ + 1 < NREP(j)) FORCEBAR(); }
#define CNTP(r) (WSP(unsigned, WS_CNT) + (li * 4 + (r)) * 64)


template <int li>
DI void layer_phases(unsigned char* smem, LAS unsigned char* ldsL, const int lo, const int hi) {
        const int pb = 2 + 8 * li;
        REPBEG(2) if (IN(pb)) {
            for (int srep_ = 0; srep_ < NSUB(0); ++srep_) if (SUBEN(0)) { KParamsPtr kp = kparams(); unsigned char* ws = kp->ws;
              SchedProjTok S{(unsigned)(WS_WTOK + (size_t)li * SZ_WTOK), (int)gridDim.x, vcu(), li == DEPTH - 1};
              { LAS float* rl = (LAS float*)(ldsL + LDS_ROPE); const float* rg = WSP(const float, WS_ROPE);
                for (int idx = ld_tid(); idx < 65 * 48; idx += 512) { int tb, o; if (idx < 2 * 65 * 16) { tb = idx / (65 * 16); o = idx % (65 * 16); } else { const int j = idx - 2 * 65 * 16; tb = 2 + j / (65 * 8); o = j % (65 * 8); }
                    const int w = tb < 2 ? 16 : 8, pos = o / w, f = o % w; const bool cosine = (tb & 1) == 0;
                    rl[idx] = pos < 64 ? rg[(tb < 2 ? tb * 1024 : 2048 + (tb - 2) * 512) + pos * w + f] : (cosine ? 1.0f : 0.0f); }
                __syncthreads(); }
              EpiProjTok E{li, (LAS const float*)(ldsL + LDS_ROPE)};
              pg8::gemm_phase<EpiProjTok, SchedProjTok, false>(ldsL, ws, 2048u, 2048u, 16, S, E); }
            for (int srep_ = 0; srep_ < NSUB(1); ++srep_) if (SUBEN(1)) { KParamsPtr kp = kparams(); unsigned char* ws = kp->ws;
              SchedProjCh S{(unsigned)(WS_WCH + (size_t)li * SZ_WCH), (int)gridDim.x, (int)((vcu() + gridDim.x - 48) % gridDim.x), li == DEPTH - 1};
              EpiProjCh E{};
              pg8::gemm_phase<EpiProjCh, SchedProjCh, true>(ldsL, ws, 2048u, 2048u, 16, S, E); }
        }
        REPEND(2)
        SEAM(pb);
        REPBEG(3) if (IN(pb + 1)) {
            { KParamsPtr kp = kparams(); unsigned char* ws = kp->ws;
              fft_load_a(smem + FF1_A, WSP(const bf16_t, WS_M1), 128);
              for (int L = blockIdx.x; L < 512; L += gridDim.x) fft1_unit(smem, ws, L);
              asm volatile("s_waitcnt vmcnt(0)" ::: "memory"); __syncthreads();
              if (threadIdx.x == 0) { __builtin_amdgcn_fence(__ATOMIC_RELEASE, "agent"); (void)xb_add(CNTP(3), 1u); } }
            for (int srep_ = 0; srep_ < NSUB(2); ++srep_) if (SUBEN(2)) { KParamsPtr kp = kparams(); unsigned char* ws = kp->ws; const int G = gridDim.x, lane = ld_tid() & 63;
              const float lam_init = 0.8f - 0.6f * __expf(-0.3f * (float)li);
              float lam;
              { const float* dl = kp->d_lambda + li * 128; float a = 0.f, b = 0.f; if (lane < 32) { a = dl[lane] * dl[32 + lane]; b = dl[64 + lane] * dl[96 + lane]; }
                lam = __expf(wave_sum(a)) - __expf(wave_sum(b)) + lam_init; }
              bf16_t* QD = WSP(bf16_t, WS_QD); bf16_t* KD = WSP(bf16_t, WS_KD); bf16_t* VTD = WSP(bf16_t, WS_VTD); bf16_t* CAT = WSP(bf16_t, WS_CAT);
              for (int L = blockIdx.x; L < (li == DEPTH - 1 ? 512 : 512 + 32); L += G) {
                AttnArgs a; int b, hd, qrow;
                if (L < 512) { b = L >> 6; hd = (L >> 4) & 3; qrow = b * SEQ + (L & 15) * 256; a.t0 = 0; } else { const int j = L - 512; b = j >> 2; hd = j & 3; qrow = NLAT + b * CTX; a.t0 = 64; }
                a.t1 = 68; a.q = QD + (size_t)qrow * 256 + hd * 64; a.klat = KD + (size_t)(b * SEQ) * 256 + hd * 64; a.kctx = KD + (size_t)(NLAT + b * CTX) * 256 + hd * 64; a.kpitch = 256;
                a.vt = VTD + (size_t)((b * 4 + hd) * 64) * KEYS; a.out = CAT + (size_t)qrow * 1024 + 768 + hd * 64; a.lam = lam; a.oscale = 1.0f - lam_init; a.subg = kp->d_subg + li * 64; a.wl = -1; a.wli = li;
                attn_unit_d8(smem, a);
              } }
            { KParamsPtr kq = kparams(); unsigned* bar = (unsigned*)(kq->ws + WS_BAR); unsigned* flag = (unsigned*)(kq->ws + WS_CNT) + (li * 4 + 3) * 64;
              if (threadIdx.x == 0) { const unsigned G_ = gridDim.x; XB_SPIN(xb_ld(flag) < G_, bar); __builtin_amdgcn_fence(__ATOMIC_ACQUIRE, "agent"); asm volatile("s_waitcnt vmcnt(0)" ::: "memory"); }
              __syncthreads(); }
            { KParamsPtr kp = kparams(); unsigned char* ws = kp->ws;
              fft_load_a(smem + FF3_A, WSP(const bf16_t, WS_M3), 64);
              for (int L = blockIdx.x; L < 512; L += gridDim.x) fft3_unit(smem, ws, L); }
            for (int srep_ = 0; srep_ < NSUB(3); ++srep_) if (SUBEN(3)) { KParamsPtr kp = kparams(); unsigned char* ws = kp->ws; const int G = gridDim.x;
              bf16_t* QA = WSP(bf16_t, WS_QA); bf16_t* KA = WSP(bf16_t, WS_KA); bf16_t* VTA = WSP(bf16_t, WS_VTA); bf16_t* CAT = WSP(bf16_t, WS_CAT);
              for (int it = 0; ; ++it) {
                int L = (int)blockIdx.x + it * G;
                if (G == 256 && it == 2) { const int j = (int)blockIdx.x - 32; if (j < 0 || j >= 32) break; L = 512 + j; }
                if (L >= (li == DEPTH - 1 ? 512 : 512 + 32)) break;
                AttnArgs a; int b, hd, qrow;
                if (L < 512) { b = L >> 6; hd = (L >> 4) & 3; qrow = b * SEQ + (L & 15) * 256; a.t0 = 0; } else { const int j = L - 512; b = j >> 2; hd = j & 3; qrow = NLAT + b * CTX; a.t0 = 64; }
                a.t1 = 68; a.q = QA + (size_t)qrow * 256 + hd * 64; a.klat = KA + (size_t)(b * SEQ) * 128 + (hd >> 1) * 64; a.kctx = KA + (size_t)(NLAT + b * CTX) * 128 + (hd >> 1) * 64; a.kpitch = 128;
                a.vt = VTA + (size_t)((b * 2 + (hd >> 1)) * 64) * KEYS; a.out = CAT + (size_t)qrow * 1024 + hd * 64; a.lam = 0.f; a.oscale = 1.f; a.subg = nullptr; a.wl = L < 512 ? L : -1; a.wli = li;
                attn_unit_a8(smem, a);
              } }
            for (int srep_ = 0; srep_ < NSUB(5); ++srep_) if (SUBEN(5) && li < DEPTH - 1) { KParamsPtr kp = kparams(); unsigned char* ws = kp->ws;
              SchedFourCtx S{(int)gridDim.x, (int)((blockIdx.x + gridDim.x - 96 % gridDim.x) % gridDim.x)}; EpiFourier E{};
              pg8::gemm_phase<EpiFourier, SchedFourCtx, true>(ldsL, ws, 1024u, 1024u, 8, S, E); }
            for (int srep_ = 0; srep_ < NSUB(6); ++srep_) if (SUBEN(6)) { KParamsPtr kp = kparams(); unsigned char* ws = kp->ws; const int G = gridDim.x;
              for (int it = 0; ; ++it) {
                int L = (int)blockIdx.x + it * G;
                if (G == 256 && it == 2) { const int j = (int)blockIdx.x - 64; if (j < 0 || j >= 32) break; L = 512 + j; }
                if (L >= (li == DEPTH - 1 ? 512 : 512 + 32)) break;
                int seqrow, Ls, t0;
                if (L < 512) { seqrow = (L >> 6) * SEQ; Ls = SEQ; t0 = (L & 63) * 64; } else { const int j = L - 512; seqrow = NLAT + (j >> 2) * CTX; Ls = CTX; t0 = (j & 3) * 64; }
                conv_unit(smem, seqrow, Ls, t0, WSP(const bf16_t, WS_BU), WSP(const bf16_t, WS_BG), kp->conv_w + li * 31 * 256, kp->conv_b + li * 256, kp->conv_lg + li * 256, kp->conv_lb + li * 256, WSP(bf16_t, WS_CAT));
              } }
        }
        REPEND(3)
        SEAM(pb + 1);
        REPBEG(4) if (IN(pb + 2)) { KParamsPtr kp = kparams(); unsigned char* ws = kp->ws;
            SchedOut S{(unsigned)(WS_WOUT + (size_t)li * SZ_WOUT), (int)gridDim.x, vcu(), li == DEPTH - 1 ? 128 : NTILE_TOK};
            EpiOut E{li};
            pg8::gemm_phase<EpiOut, SchedOut, false>(ldsL, ws, 2048u, 2048u, 16, S, E);
        }
        REPEND(4)
        SEAM(pb + 2);
        REPBEG(5) if (IN(pb + 3)) { const Params P = *kparams(); unsigned char* ws = P.ws;
            phase_router(smem, P, li, WSP(const bf16_t, WS_X1), WSP(unsigned char, WS_H8), WSP(const float, WS_MOD) + (size_t)li * 9 * 6144, CNTP(rep_), WSP(int, WS_TOKE), WSP(int, WS_TOKP), WSP(float, WS_TOKG), WSP(int, WS_TOKL), gridDim.x, li == DEPTH - 1 ? NLAT : NTOK, li == DEPTH - 1 ? 128 : RT_CH); }
        REPEND(5)
        SEAM(pb + 3);
        REPBEG(7) if (IN(pb + 5)) { KParamsPtr kp = kparams(); unsigned char* ws = kp->ws; LAS int* tab = (LAS int*)(ldsL + LDS_TAB);
            moe_tables(tab, CNTP(NREP(5) - 1));
            SchedMoe<8, true> S{0u, (unsigned)(WS_WGU + (size_t)li * SZ_WGU), 2048u * 1024u, tab, (int)gridDim.x, (int)blockIdx.x};
            EpiMoe1 E{li};
            pg8::gemm_phase<EpiMoe1, SchedMoe<8, true>, false, true, true>(ldsL, ws, 1024u, 1024u, 8, S, E); }
        REPEND(7)
        SEAM(pb + 5);
        REPBEG(8) if (IN(pb + 6)) { KParamsPtr kp = kparams(); unsigned char* ws = kp->ws; LAS int* tab = (LAS int*)(ldsL + LDS_TAB);
            moe_tables(tab, CNTP(NREP(5) - 1));
            SchedMoe<4> S{(unsigned)WS_ACT, (unsigned)(WS_WDN + (size_t)li * SZ_WDN), 1024u * 1024u, tab, (int)gridDim.x, (int)blockIdx.x};
            EpiMoe2 E{li};
            pg8::gemm_phase<EpiMoe2, SchedMoe<4>, false, true>(ldsL, ws, 1024u, 1024u, 8, S, E); }
        REPEND(8)
        SEAM(pb + 6);
        REPBEG(9) if (IN(pb + 7)) { const Params P = *kparams(); unsigned char* ws = P.ws; const float* MOD = WSP(const float, WS_MOD); LAS int* tab = (LAS int*)(ldsL + LDS_TAB);
            moe_tables(tab, CNTP(NREP(5) - 1));
            phase_combine(P, li, WSP(const bf16_t, WS_X1), WSP(bf16_t, WS_X2), WSP(const unsigned char, WS_XP) + (size_t)MAXMT * 256 * 1024, tab, WSP(const int, WS_TOKE), WSP(const int, WS_TOKP), WSP(const float, WS_TOKG), MOD + (size_t)li * 9 * 6144, MOD + (size_t)(li + 1 < DEPTH ? li + 1 : li) * 9 * 6144, WSP(bf16_t, WS_H), gridDim.x); }
        REPEND(9)
        SEAM(pb + 7);
}

__global__ void __launch_bounds__(512, 2) mega(Params Pdummy) {
    extern __shared__ __attribute__((aligned(16))) unsigned char smem[];
    LAS unsigned char* ldsL = (LAS unsigned char*)smem;
    if (threadIdx.x < 4) ((LAS unsigned*)(ldsL + LDS_BARW))[threadIdx.x] = 0u;
    __syncthreads();
    { KParamsPtr kp = kparams(); (void)xcd_barrier_post((unsigned*)(kp->ws + WS_BAR), (volatile LAS unsigned*)(ldsL + LDS_BARW)); }
    int lo, hi; { KParamsPtr kp = kparams(); lo = kp->ph_lo; hi = kp->ph_hi; }
    REPBEG(0) if (IN(0)) { const Params P = *kparams(); phase_prep(smem, P, gridDim.x); } REPEND(0)
    SEAM(0);
    REPBEG(1) if (IN(1)) { const Params P = *kparams(); unsigned char* ws = P.ws; phase_norm1(P, WSP(bf16_t, WS_H), WSP(const float, WS_MOD), gridDim.x); } REPEND(1)
    SEAM(1);
    layer_phases<0>(smem, ldsL, lo, hi);
    layer_phases<1>(smem, ldsL, lo, hi);
    static_assert(DEPTH == 2, "two layers are written out");
#undef IN
#undef SEAM
}

#ifndef MK_MULTI
#define MK_MULTI 0
#endif
extern "C" void kernel_launch(void* const* d_in, const int* in_sizes, int n_in, void* d_out, int out_size, void* d_ws, size_t ws_size, hipStream_t stream) {
    static int grid = 0;
    if (grid == 0) {
        if (n_in != 26 || ws_size < WS_END) { fprintf(stderr, "kernel_launch: need 26 inputs and %zu bytes of workspace (got %d, %zu)\n", (size_t)WS_END, n_in, ws_size); grid = -1; return; }
        int dev = 0, cus = 0, per_cu = 0;
        if (hipGetDevice(&dev) != hipSuccess || hipDeviceGetAttribute(&cus, hipDeviceAttributeMultiprocessorCount, dev) != hipSuccess) { grid = -1; return; }
        if (hipFuncSetAttribute((const void*)mega, hipFuncAttributeMaxDynamicSharedMemorySize, LDS_BYTES) != hipSuccess) { fprintf(stderr, "kernel_launch: hipFuncSetAttribute failed\n"); grid = -1; return; }
        if (hipOccupancyMaxActiveBlocksPerMultiprocessor(&per_cu, (const void*)mega, 512, LDS_BYTES) != hipSuccess || per_cu < 1) fprintf(stderr, "kernel_launch: occupancy query says %d\n", per_cu);
        (void)hipGetLastError();
        grid = cus;
    }
    if (grid < 0) return;
    (void)hipMemsetAsync(d_ws, 0, WS_ZERO_BYTES, stream);
    Params p{};
    const float** pf = (const float**)&p;
    for (int i = 0; i < 26; ++i) pf[i] = (const float*)d_in[i];
    p.out = (float*)d_out; p.ws = (unsigned char*)d_ws;
#if MK_MULTI
    for (int k = 0; k < NPHASE; ++k) { p.ph_lo = k; p.ph_hi = k + 1; hipLaunchKernelGGL(mega, dim3(grid), dim3(512), LDS_BYTES, stream, p); }
#else
    p.ph_lo = 0; p.ph_hi = NPHASE;
    hipLaunchKernelGGL(mega, dim3(grid), dim3(512), LDS_BYTES, stream, p);
#ifdef EXTRA_PHASE
    p.ph_lo = EXTRA_PHASE; p.ph_hi = EXTRA_PHASE + 1;
    hipLaunchKernelGGL(mega, dim3(grid), dim3(512), LDS_BYTES, stream, p);
#endif
#endif
}
```
